# Optimizing an MI355X kernel written in HIP

```python
import jax, jax.numpy as jnp
from jax import lax
import numpy as np

D_MODEL = 1024
BATCH = 8
SEQ = 4096
DEPTH = 2

HG_HEADS = 4
HG_DK = 128
HG_W = HG_HEADS * HG_DK
RET_HEADS = 4
RET_DK = 128
RET_W = RET_HEADS * RET_DK
RW_HEADS = 8
RW_N = 64
RW_W = RW_HEADS * RW_N
RW_DECAY_LORA = 64
RW_A_LORA = 64
RW_GATE_LORA = 128
RW_GN_EPS = 64e-5
N_BRANCH = 3
HG_COLS = 4 * HG_W
RET_COLS = 4 * RET_W
RW_COLS = 3 * RW_W + RW_DECAY_LORA + RW_A_LORA + RW_GATE_LORA
GATE_COLS = N_BRANCH * D_MODEL
IN_COLS = HG_COLS + RET_COLS + RW_COLS + GATE_COLS
CHUNK = 64
N_GROUPS = 4
EXPERTS_PER_GROUP = 8
N_EXPERTS = N_GROUPS * EXPERTS_PER_GROUP
TOP_K_IN_GROUP = 2
D_EXPERT = 512

ROPE_THETA = 10000.0
NORM_EPS = 1e-6

kernel_name = 'hybrid_hgrn2_retnet_rwkv7_hmoe'


def split_cols(z, sizes):
    offs = np.cumsum([0] + list(sizes))
    return [z[..., int(offs[i]):int(offs[i + 1])] for i in range(len(sizes))]


def split_heads(z, n_heads):
    b, t, w = z.shape
    return z.reshape(b, t, n_heads, w // n_heads)


def to_chunks(z):
    b, t, h, d = z.shape
    return z.reshape(b, t // CHUNK, CHUNK, h, d).transpose(0, 3, 1, 2, 4)


def from_chunks(z):
    b, h, nc, l, d = z.shape
    return z.transpose(0, 2, 3, 1, 4).reshape(b, nc * l, h, d)


def rmsnorm(x, gain):
    xf = x.astype(jnp.float32)
    y = xf * lax.rsqrt(jnp.mean(xf * xf, axis=-1, keepdims=True) + NORM_EPS)
    return (y * gain.astype(jnp.float32)).astype(x.dtype)


def head_rmsnorm(o):
    return o * lax.rsqrt(jnp.mean(o * o, axis=-1, keepdims=True) + NORM_EPS)


def rope(z, positions):
    d = z.shape[-1]
    inv_freq = ROPE_THETA ** (-jnp.arange(0, d, 2, dtype=jnp.float32) / d)
    ang = positions.astype(jnp.float32)[:, :, None, None] * inv_freq
    cos, sin = jnp.cos(ang), jnp.sin(ang)
    z1, z2 = z[..., : d // 2], z[..., d // 2:]
    return jnp.concatenate([z1 * cos - z2 * sin, z1 * sin + z2 * cos], axis=-1)


def hgrn2_mixer(zq, zf, zi, zg, lower_bound, norm_w):
    f32 = jnp.float32
    dtype = zq.dtype
    f = lower_bound + (1.0 - lower_bound) * jax.nn.sigmoid(zf.astype(f32))
    log_f = jnp.log(jnp.maximum(f, 1e-30))
    q = jax.nn.silu(zq.astype(f32)) * (HG_DK ** -0.5)
    k = 1.0 - f
    v = zi.astype(f32)
    qc, kc, gc, vc = (to_chunks(split_heads(a, HG_HEADS)) for a in (q, k, log_f, v))
    b, h, nc, l, dk = qc.shape
    causal = jnp.tril(jnp.ones((CHUNK, CHUNK), dtype=bool))[:, :, None]

    def chunk_step(S, inp):
        q_, k_, g_, v_ = inp
        cum = jnp.cumsum(g_, axis=2)
        diff = cum[:, :, :, None, :] - cum[:, :, None, :, :]
        decay = jnp.exp(jnp.where(causal, diff, -jnp.inf))
        scores = jnp.einsum('bhtd,bhsd,bhtsd->bhts', q_, k_, decay)
        o = jnp.einsum('bhts,bhsv->bhtv', scores, v_) + jnp.einsum('bhtd,bhdv->bhtv', q_ * jnp.exp(cum), S)
        last = cum[:, :, -1:, :]
        S = jnp.exp(last[:, :, 0, :])[..., None] * S + jnp.einsum('bhsd,bhsv->bhdv', k_ * jnp.exp(last - cum), v_)
        return S, o

    S0 = jnp.zeros((b, h, dk, vc.shape[-1]), f32)
    _, o = lax.scan(chunk_step, S0, tuple(jnp.moveaxis(a, 2, 0) for a in (qc, kc, gc, vc)))
    o = from_chunks(jnp.moveaxis(o, 0, 2))
    o = head_rmsnorm(o) * norm_w.astype(f32) * jax.nn.silu(split_heads(zg.astype(f32), HG_HEADS))
    bb, t = o.shape[:2]
    return o.reshape(bb, t, HG_W).astype(dtype)


def retention_mixer(zq, zk, zv, zg, positions):
    f32 = jnp.float32
    dtype = zq.dtype
    q = rope(split_heads(zq.astype(f32), RET_HEADS), positions) * (RET_DK ** -0.5)
    k = rope(split_heads(zk.astype(f32), RET_HEADS), positions)
    v = split_heads(zv.astype(f32), RET_HEADS)
    qc, kc, vc = (to_chunks(a) for a in (q, k, v))
    log_gamma = jnp.log(1.0 - 2.0 ** (-5.0 - jnp.arange(RET_HEADS, dtype=f32)))
    j = jnp.arange(CHUNK, dtype=f32)
    rel = j[:, None] - j[None, :]
    causal = rel >= 0
    dmask = jnp.where(causal, jnp.exp(jnp.where(causal, rel, 0.0)[None] * log_gamma[:, None, None]), 0.0)
    scores = jnp.einsum('bhctd,bhcsd->bhcts', qc, kc) * dmask[None, :, None]
    inner = jnp.einsum('bhcts,bhcsv->bhctv', scores, vc)
    zeta = jnp.exp((CHUNK - 1.0 - j)[None, :] * log_gamma[:, None])
    kv = jnp.einsum('bhcsd,hs,bhcsv->cbhdv', kc, zeta, vc)
    chunk_decay = jnp.exp(CHUNK * log_gamma)[None, :, None, None]

    def step(R, kv_c):
        return chunk_decay * R + kv_c, R

    _, r_before = lax.scan(step, jnp.zeros(kv.shape[1:], f32), kv)
    xi = jnp.exp((j + 1.0)[None, :] * log_gamma[:, None])
    cross = jnp.einsum('bhctd,ht,cbhdv->bhctv', qc, xi, r_before)
    o = from_chunks(inner + cross)
    o = head_rmsnorm(o) * jax.nn.silu(split_heads(zg.astype(f32), RET_HEADS))
    bb, t = o.shape[:2]
    return o.reshape(bb, t, RET_W).astype(dtype)


def rwkv7_mixer(z, mu, w0, w2, a0, a2, g2, k_k, k_a, r_k, ln_w, ln_b):
    f32 = jnp.float32
    dtype = z.dtype
    z = z.astype(f32)
    z_prev = jnp.pad(z[:, :-1], ((0, 0), (1, 0), (0, 0)))
    z = z + mu * (z_prev - z)
    r, k, v, w_lo, a_lo, g_lo = split_cols(z, (RW_W, RW_W, RW_W, RW_DECAY_LORA, RW_A_LORA, RW_GATE_LORA))
    w = -jax.nn.softplus(-(w0 + jnp.tanh(w_lo) @ w2)) - 0.5
    decay = jnp.exp(-jnp.exp(w))
    a = jax.nn.sigmoid(a0 + a_lo @ a2)
    g = jax.nn.sigmoid(g_lo) @ g2
    kk = split_heads(k * k_k, RW_HEADS)
    kk = kk * lax.rsqrt(jnp.maximum(jnp.sum(kk * kk, axis=-1, keepdims=True), 1e-24))
    k = k * (1.0 + (a - 1.0) * k_a)
    rh, wh, kh, vh, ah = (split_heads(t, RW_HEADS) for t in (r, decay, k, v, a))

    def step(S, inp):
        r_, w_, k_, v_, kk_, a_ = inp
        sa = jnp.einsum('bhvk,bhk->bhv', S, -kk_)
        S = S * w_[:, :, None, :] + sa[..., None] * (kk_ * a_)[:, :, None, :] + v_[..., None] * k_[:, :, None, :]
        return S, jnp.einsum('bhvk,bhk->bhv', S, r_)

    bb, t = z.shape[:2]
    S0 = jnp.zeros((bb, RW_HEADS, RW_N, RW_N), f32)
    _, o = lax.scan(step, S0, tuple(jnp.moveaxis(a_, 1, 0) for a_ in (rh, wh, kh, vh, kk, ah)))
    o = jnp.moveaxis(o, 0, 1)
    mean = jnp.mean(o, axis=-1, keepdims=True)
    var = jnp.mean(jnp.square(o - mean), axis=-1, keepdims=True)
    o = ((o - mean) * lax.rsqrt(var + RW_GN_EPS)).reshape(bb, t, RW_W) * ln_w + ln_b
    bonus = (jnp.sum(rh * kh * r_k, axis=-1, keepdims=True) * vh).reshape(bb, t, RW_W)
    return ((o + bonus) * g).astype(dtype)


def token_mixer(h, positions, lower_bound, w_in, hg_norm_w, rw_mu, rw_w0, rw_w2, rw_a0, rw_a2, rw_g2,
                rw_k_k, rw_k_a, rw_r_k, rw_ln_w, rw_ln_b, br_hg, br_ret, br_rw, w_out):
    z = h @ w_in
    z_hg, z_ret, z_rw, z_gate = split_cols(z, (HG_COLS, RET_COLS, RW_COLS, GATE_COLS))
    y_hg = hgrn2_mixer(*split_cols(z_hg, (HG_W,) * 4), lower_bound, hg_norm_w) @ br_hg
    y_ret = retention_mixer(*split_cols(z_ret, (RET_W,) * 4), positions) @ br_ret
    y_rw = rwkv7_mixer(z_rw, rw_mu, rw_w0, rw_w2, rw_a0, rw_a2, rw_g2, rw_k_k, rw_k_a, rw_r_k,
                       rw_ln_w, rw_ln_b) @ br_rw
    gates = jax.nn.sigmoid(z_gate.astype(jnp.float32)).astype(h.dtype)
    g_hg, g_ret, g_rw = split_cols(gates, (D_MODEL,) * N_BRANCH)
    return (g_hg * y_hg + g_ret * y_ret + g_rw * y_rw) @ w_out


def hier_moe(h, router_g, router_e, w1, w3, w2):
    b, t, d = h.shape
    hf = h.reshape(b * t, d)
    g_logits = (hf @ router_g).astype(jnp.float32)
    g_idx = jnp.argmax(g_logits, axis=-1)
    g_w = jnp.take_along_axis(jax.nn.softmax(g_logits, axis=-1), g_idx[:, None], axis=-1)
    e_logits = (hf @ router_e).astype(jnp.float32).reshape(b * t, N_GROUPS, EXPERTS_PER_GROUP)
    e_logits = jnp.take_along_axis(e_logits, g_idx[:, None, None], axis=1)[:, 0]
    top_p, top_i = lax.top_k(jax.nn.softmax(e_logits, axis=-1), TOP_K_IN_GROUP)
    top_p = top_p / jnp.sum(top_p, axis=-1, keepdims=True)
    expert_id = g_idx[:, None] * EXPERTS_PER_GROUP + top_i
    combine = jnp.sum(jax.nn.one_hot(expert_id, N_EXPERTS, dtype=jnp.float32) * (g_w * top_p)[..., None], axis=1)
    combine = combine.astype(h.dtype).T

    def expert_step(acc, p):
        w1_e, w3_e, w2_e, c_e = p
        y = (jax.nn.silu(hf @ w1_e) * (hf @ w3_e)) @ w2_e
        return acc + c_e[:, None] * y, None

    y, _ = lax.scan(expert_step, jnp.zeros_like(hf), (w1, w3, w2, combine))
    return y.reshape(b, t, d)


def setup_inputs(seed: int = 0) -> dict:
    key = jax.random.key(seed)
    keys = iter(jax.random.split(key, 48))

    def nrm(shape, scale):
        return jax.random.normal(next(keys), shape, jnp.float32) * scale

    def unif(shape, lo, hi):
        return jax.random.uniform(next(keys), shape, jnp.float32, lo, hi)

    L = DEPTH
    x = nrm((BATCH, SEQ, D_MODEL), 1.0)
    c = nrm((BATCH, D_MODEL), 1.0)
    offsets = jax.random.randint(next(keys), (BATCH, 1), 0, SEQ, dtype=jnp.int32)
    positions = offsets + jnp.arange(SEQ, dtype=jnp.int32)[None, :]
    return {
        'x': x,
        'c': c,
        'positions': positions,
        'ada_w': nrm((L, D_MODEL, 6 * D_MODEL), 0.5 * D_MODEL ** -0.5),
        'ada_b': nrm((L, 6 * D_MODEL), 0.02),
        'norm1_g': 1.0 + nrm((L, D_MODEL), 0.05),
        'norm2_g': 1.0 + nrm((L, D_MODEL), 0.05),
        'w_in': nrm((L, D_MODEL, IN_COLS), D_MODEL ** -0.5),
        'hg_lb_table': nrm((L, HG_W), 0.5),
        'hg_norm_w': 1.0 + nrm((L, HG_DK), 0.05),
        'rw_mu': unif((L, RW_COLS), 0.0, 1.0),
        'rw_w0': unif((L, RW_W), -6.5, -1.5),
        'rw_w2': nrm((L, RW_DECAY_LORA, RW_W), 0.1 * RW_DECAY_LORA ** -0.5),
        'rw_a0': nrm((L, RW_W), 0.5),
        'rw_a2': nrm((L, RW_A_LORA, RW_W), 0.5 * RW_A_LORA ** -0.5),
        'rw_g2': nrm((L, RW_GATE_LORA, RW_W), RW_GATE_LORA ** -0.5),
        'rw_k_k': 0.85 + nrm((L, RW_W), 0.05),
        'rw_k_a': 1.0 + nrm((L, RW_W), 0.05),
        'rw_r_k': nrm((L, RW_HEADS, RW_N), 0.1),
        'rw_ln_w': 1.0 + nrm((L, RW_W), 0.05),
        'rw_ln_b': nrm((L, RW_W), 0.02),
        'br_hg': nrm((L, HG_W, D_MODEL), HG_W ** -0.5),
        'br_ret': nrm((L, RET_W, D_MODEL), RET_W ** -0.5),
        'br_rw': nrm((L, RW_W, D_MODEL), RW_W ** -0.5),
        'w_out': nrm((L, D_MODEL, D_MODEL), D_MODEL ** -0.5),
        'router_g': nrm((L, D_MODEL, N_GROUPS), D_MODEL ** -0.5),
        'router_e': nrm((L, D_MODEL, N_EXPERTS), D_MODEL ** -0.5),
        'moe_w1': nrm((L, N_EXPERTS, D_MODEL, D_EXPERT), D_MODEL ** -0.5),
        'moe_w3': nrm((L, N_EXPERTS, D_MODEL, D_EXPERT), D_MODEL ** -0.5),
        'moe_w2': nrm((L, N_EXPERTS, D_EXPERT, D_MODEL), D_EXPERT ** -0.5),
        'final_g': 1.0 + nrm((D_MODEL,), 0.05),
    }


def reference(x, c, positions, ada_w, ada_b, norm1_g, norm2_g, w_in, hg_lb_table, hg_norm_w, rw_mu, rw_w0,
              rw_w2, rw_a0, rw_a2, rw_g2, rw_k_k, rw_k_a, rw_r_k, rw_ln_w, rw_ln_b, br_hg, br_ret, br_rw, w_out,
              router_g, router_e, moe_w1, moe_w3, moe_w2, final_g):
    lb_p = jax.nn.softmax(hg_lb_table.astype(jnp.float32), axis=0)
    lower_bounds = jnp.cumsum(lb_p, axis=0) - lb_p[0]
    cond = jax.nn.silu(c)
    for l in range(DEPTH):
        mod = cond @ ada_w[l] + ada_b[l]
        shift1, scale1, gate1, shift2, scale2, gate2 = jnp.split(mod[:, None, :], 6, axis=-1)
        h = rmsnorm(x, norm1_g[l]) * (1.0 + scale1) + shift1
        y = token_mixer(h, positions, lower_bounds[l], w_in[l], hg_norm_w[l], rw_mu[l], rw_w0[l], rw_w2[l],
                        rw_a0[l], rw_a2[l], rw_g2[l], rw_k_k[l], rw_k_a[l], rw_r_k[l], rw_ln_w[l], rw_ln_b[l],
                        br_hg[l], br_ret[l], br_rw[l], w_out[l])
        x = x + gate1 * y
        h = rmsnorm(x, norm2_g[l]) * (1.0 + scale2) + shift2
        x = x + gate2 * hier_moe(h, router_g[l], router_e[l], moe_w1[l], moe_w3[l], moe_w2[l])
    return rmsnorm(x, final_g)
```

```cpp
#include <hip/hip_runtime.h>
#include <cstdio>

#define LAS __attribute__((address_space(3)))
#define DEV __device__ __forceinline__
typedef unsigned short bf16_t;
typedef short bf16x8 __attribute__((ext_vector_type(8)));
typedef float f32x4 __attribute__((ext_vector_type(4)));
typedef float f32x2 __attribute__((ext_vector_type(2)));
typedef unsigned u32x4 __attribute__((ext_vector_type(4)));
typedef unsigned u32x2 __attribute__((ext_vector_type(2)));

#ifndef MK_LAUNCH_PER_PHASE
#define MK_LAUNCH_PER_PHASE 0
#endif

constexpr int NB = 8, T = 4096, D = 1024, NTOK = NB * T, DEPTH = 2;
constexpr int INC = 8960, ZMIXC = 5888, GATEC = 3072;
constexpr int NEXP = 32, DEXP = 512;
constexpr int RMAX = 2 * NTOK + NEXP * 256;
constexpr float NORM_EPS = 1e-6f, RW_GN_EPS = 64e-5f;
constexpr size_t MiB = (size_t)1 << 20;
constexpr size_t BLK_E = (size_t)NTOK * 256;
constexpr size_t BLK_B = BLK_E * 2;

constexpr size_t WS_CTL = 0;
constexpr size_t CTL_ZERO_BYTES = 64 * 1024;
constexpr size_t WS_MODP = 1 * MiB;
constexpr size_t WS_MOD = 4 * MiB;
constexpr size_t WS_LB = 4 * MiB + 512 * 1024;
constexpr size_t WS_HGSIDE = 5 * MiB;
constexpr size_t WS_SEL_E = 8 * MiB;
constexpr size_t WS_SEL_W = WS_SEL_E + 256 * 1024;
constexpr size_t WS_SEL_P = WS_SEL_W + 256 * 1024;
constexpr size_t WS_CNT = WS_SEL_P + 256 * 1024;
constexpr size_t WS_TILEMAP = WS_CNT + 64 * 1024;
constexpr size_t WS_ROWTOK = 9 * MiB;
constexpr size_t WS_RK = 10 * MiB;
constexpr size_t WS_WIN = 16 * MiB;
constexpr size_t WS_BR = 51 * MiB;
constexpr size_t WS_WOUT = 57 * MiB;
constexpr size_t WS_LORAB = 61 * MiB;
constexpr size_t WS_H = 64 * MiB;
constexpr size_t WS_POOL = 128 * MiB;
constexpr size_t WS_END = 640 * MiB;
constexpr int BK_HGQ = 0, BK_HGF = 2, BK_HGI = 4, BK_HGG = 6, BK_RTQ = 8, BK_RTK = 10, BK_RTV = 12, BK_RTG = 14;
constexpr int BK_RWR = 16, BK_RWK = 18, BK_RWV = 20, BK_RWL = 22, BK_LIN = 23, BK_LW = 24, BK_LA = 26, BK_LG = 28, BK_RWO = 30;
constexpr int BK_YF = 16;
constexpr int BK_YB = 24;
constexpr size_t PO_HPERM = 0;
constexpr size_t PO_ACT = 144 * MiB;
constexpr size_t PO_Y2 = 216 * MiB;
constexpr size_t PO_W13 = 360 * MiB;
constexpr size_t PO_W2 = 424 * MiB;

constexpr int LDS_BYTES = 163840;
constexpr int LDS_MISC = 163840 - 64;

DEV float bf2f(unsigned v) { return __uint_as_float(v << 16); }
typedef __bf16 bf16n2 __attribute__((ext_vector_type(2)));
DEV unsigned f2bf(float f) { return (unsigned)__builtin_bit_cast(unsigned short, (__bf16)f); }
DEV unsigned pk2(float lo, float hi) { const f32x2 v = {lo, hi}; return __builtin_bit_cast(unsigned, __builtin_convertvector(v, bf16n2)); }
DEV float sigm(float x) { return __builtin_amdgcn_rcpf(1.f + __expf(-x)); }
DEV float silu(float x) { return x * __builtin_amdgcn_rcpf(1.f + __expf(-x)); }
DEV int opaque_tid() { int t = threadIdx.x; asm volatile("" : "+v"(t)); return t; }
DEV int ld_vec_i(const int* p) { return __hip_atomic_load(p, __ATOMIC_RELAXED, __HIP_MEMORY_SCOPE_AGENT); }
DEV float ld_vec_f(const float* p) { return __hip_atomic_load(p, __ATOMIC_RELAXED, __HIP_MEMORY_SCOPE_AGENT); }
DEV float wave_sum(float v) {
#pragma unroll
    for (int o = 1; o < 64; o <<= 1) v += __shfl_xor(v, o);
    return v;
}
#define LDS_WAIT() asm volatile("s_waitcnt lgkmcnt(0)" ::: "memory")
#define LDS_BARRIER() do { asm volatile("s_waitcnt lgkmcnt(0)" ::: "memory"); __builtin_amdgcn_s_barrier(); asm volatile("" ::: "memory"); } while (0)

#define XB_TMO      128
#define XB_XCNT(j)  (256  + 64 * (j))
#define XB_XSUB(j)  (1280 + 64 * (j))
#define XB_XGEN(j)  (2304 + 64 * (j))
#define XB_TOP      3328
#define XB_TOPGEN   3392
#define XCD_BAR_WORDS 3456
#define XB_SPIN_CAP (1u << 20)

__device__ __forceinline__ unsigned xb_ld(unsigned* p)              { return __hip_atomic_load(p, __ATOMIC_RELAXED, __HIP_MEMORY_SCOPE_AGENT); }
__device__ __forceinline__ unsigned xb_add(unsigned* p, unsigned v) { return __hip_atomic_fetch_add(p, v, __ATOMIC_RELAXED, __HIP_MEMORY_SCOPE_AGENT); }
__device__ __forceinline__ unsigned xb_xcc_id() { return (unsigned)__builtin_amdgcn_s_getreg((3 << 11) | 20) & 0xFu; }
#define XB_SPIN(cond, bar) do { unsigned _sp = 0; while (cond) { __builtin_amdgcn_s_sleep(1); \
    if ((++_sp & 255u) == 0u) { if (xb_ld(&(bar)[XB_TMO])) break; if (_sp > XB_SPIN_CAP) { atomicAdd(&(bar)[XB_TMO], 1u); break; } } } } while (0)

struct XcdBarrier { unsigned* bar; unsigned x; volatile LAS unsigned* st; };

__device__ __forceinline__ XcdBarrier xcd_barrier_post(unsigned* bar, volatile LAS unsigned* st) {
    XcdBarrier b; b.bar = bar; b.x = xb_xcc_id(); b.st = st;
    if (threadIdx.x == 0) (void)xb_add(&bar[XB_XCNT(b.x)], 1u);
    return b;
}
__device__ __forceinline__ void xcd_barrier_complete(unsigned* bar, unsigned x, unsigned& nloc, unsigned& nx) {
    const unsigned G = gridDim.x * gridDim.y * gridDim.z;
    unsigned sum, cnt, mine, sp = 0u;
    for (;;) {
        sum = 0u; cnt = 0u; mine = 0u;
#pragma unroll
        for (unsigned j = 0; j < 16; ++j) { const unsigned c = xb_ld(&bar[XB_XCNT(j)]); sum += c; cnt += (c > 0u) ? 1u : 0u; mine = (j == x) ? c : mine; }
        if (sum == G) break;
        __builtin_amdgcn_s_sleep(1);
        if ((++sp & 255u) == 0u) { if (xb_ld(&bar[XB_TMO])) break; if (sp > XB_SPIN_CAP) { atomicAdd(&bar[XB_TMO], 1u); break; } }
    }
    nloc = mine > 0u ? mine : 1u; nx = cnt > 0u ? cnt : 1u;
}
__device__ __forceinline__ void xcd_barrier(const XcdBarrier& b) {
    asm volatile("s_waitcnt vmcnt(0)" ::: "memory");
    __syncthreads();
    if (threadIdx.x == 0) {
        unsigned* bar = b.bar;
        __builtin_amdgcn_s_waitcnt(0);
        unsigned nloc = b.st[0], nx = b.st[1];
        if (nloc == 0u) { xcd_barrier_complete(bar, b.x, nloc, nx); b.st[0] = nloc; b.st[1] = nx; }
        const unsigned old = xb_add(&bar[XB_XSUB(b.x)], 1u);
        const unsigned gen = old / nloc;
        if (old + 1u == (gen + 1u) * nloc) {
            __builtin_amdgcn_fence(__ATOMIC_RELEASE, "agent");
            asm volatile("s_waitcnt vmcnt(0)" ::: "memory");
            const unsigned og = xb_add(&bar[XB_TOP], 1u);
            const unsigned tg = og / nx;
            if (og + 1u == (tg + 1u) * nx) xb_add(&bar[XB_TOPGEN], 1u);
            else XB_SPIN(xb_ld(&bar[XB_TOPGEN]) == tg, bar);
            __builtin_amdgcn_fence(__ATOMIC_ACQUIRE, "agent");
            xb_add(&bar[XB_XGEN(b.x)], 1u);
            asm volatile("s_waitcnt vmcnt(0)" ::: "memory");
        } else {
            XB_SPIN(xb_ld(&bar[XB_XGEN(b.x)]) == gen, bar);
            __builtin_amdgcn_fence(__ATOMIC_ACQUIRE, "agent");
            asm volatile("s_waitcnt vmcnt(0)" ::: "memory");
        }
    }
    __syncthreads();
}

namespace pg8 {
constexpr int BM = 256, BK = 64, HALF = 128, HTB = HALF * BK * 2, STAGE_BYTES = 8 * HTB, NXCD = 8, WGM = 8;
__host__ __device__ __forceinline__ int lds_byte(int r, int c) { const int st = (r >> 4) * 2 + (c >> 5), rr = r & 15, cc = c & 31, ob = rr * 64 + cc * 2; return st * 1024 + (ob ^ (((ob >> 9) & 1) << 5)); }
__host__ __device__ __forceinline__ void stage_rc(int b, int& R, int& C) { const int st = b / 1024, sb = b % 1024, swz = sb ^ (((sb >> 9) & 1) << 5); R = (st >> 1) * 16 + swz / 64; C = (st & 1) * 32 + (swz % 64) / 2; }
__host__ __device__ __forceinline__ int perm32(int rho) { const int n = rho >> 4, i = rho & 15; return 8 * (i >> 2) + 4 * n + (i & 3); }

struct Unit { int pm, pn, pnb; };
struct Gemm { const bf16_t* A; const bf16_t* Bt; int K; int lda; size_t kblk; size_t seg1, seg2; };

struct DenseOrder {
    static constexpr const int* rowtok = nullptr;
    int nM, nN, nwg, G, c, pnb0;
    __device__ void init(int M, int N, int G_, int c_, int pnb0_) { nM = M / BM; nN = N / BM; nwg = nM * nN; G = G_; c = c_; pnb0 = pnb0_; }
    __device__ bool next(int i, Unit& u) const {
        const long L = (long)i * G + c; if (L >= nwg) return false;
        int wgid = (int)L; { const int q = nwg / NXCD, r = nwg % NXCD, xcd = wgid % NXCD, off = wgid / NXCD; wgid = (xcd < r ? xcd * (q + 1) : r * (q + 1) + (xcd - r) * q) + off; }
        const int nig = WGM * nN, gid = wgid / nig, fm = gid * WGM, gsz = (nM - fm) < WGM ? (nM - fm) : WGM;
        u.pm = fm + ((wgid % nig) % gsz); u.pn = (wgid % nig) / gsz; u.pnb = u.pn + pnb0; return true;
    }
};
struct MoeOrder {
    const int* tilemap; const int* rowtok; int G, c, ntiles;
    __device__ void init(const int* tm, int G_, int c_, const int* rt = nullptr) { tilemap = tm; rowtok = rt; G = G_; c = c_; ntiles = __hip_atomic_load(tm, __ATOMIC_RELAXED, __HIP_MEMORY_SCOPE_AGENT); }
    __device__ bool next(int i, Unit& u) const {
        const int L = i * G + c; if (L >= ntiles * 4) return false;
        const int ti = L >> 2; u.pm = ti; u.pn = L & 3; u.pnb = __hip_atomic_load(tilemap + 1 + ti, __ATOMIC_RELAXED, __HIP_MEMORY_SCOPE_AGENT) * 4 + u.pn; return true;
    }
};

__device__ __forceinline__ unsigned cvt_pk_bf16(float lo, float hi) { return pk2(lo, hi); }

template <bool SEG = false, bool GATH = false, class Epi, class Sched>
__device__ __forceinline__ void gemm_phase(LAS unsigned char* lds, const Gemm g, const Sched& S, const Epi& E) {
    const int tid = opaque_tid(), wid = __builtin_amdgcn_readfirstlane(tid >> 6), lane = tid & 63, wr = wid >> 2, wc = wid & 3, fr = lane & 15, fq = lane >> 4;
    const int K = g.K, nt = K / BK;
    unsigned voffA[2][2], voffN[2][2], voffB[2]; int RA[2], CA[2];
#pragma unroll
    for (int i = 0; i < 2; ++i) { int R, C; stage_rc(tid * 16 + i * 8192, R, C); const int Rb = Epi::PERM ? ((R & ~31) + perm32(R & 31)) : R;
        RA[i] = R; CA[i] = C; voffB[i] = (unsigned)(Rb * K + C) * 2u;
        voffA[0][i] = voffN[0][i] = (unsigned)(R * g.lda + C) * 2u; voffA[1][i] = voffN[1][i] = (unsigned)((R + HALF) * g.lda + C) * 2u; }
    const size_t kstep = (size_t)(BK * 2);
    const size_t hstepA = (size_t)HALF * g.lda * 2, hstepB = (size_t)HALF * K * 2;
    const size_t tstepA = 2 * hstepA, tstepB = 2 * hstepB;
    const size_t kblk = g.kblk;
    const unsigned ldsw = (unsigned)wid * 1024u;
    const int aoff = lds_byte(wr * 64 + fr, fq * 8), boff = lds_byte(wc * 32 + fr, fq * 8);
#define PG8_KOFFA(t) (SEG ? ((((t) >> 3) == 0 ? (size_t)0 : (((t) >> 3) == 1 ? g.seg1 : g.seg2)) + (size_t)(((t) >> 2) & 1) * kblk + (size_t)((t) & 3) * 128) : ((size_t)((t) >> 2) * kblk + (size_t)((t) & 3) * 128))
#define PG8_SA(b, h) (((b) * 2 + (h)) * HTB)
#define PG8_SB(b, h) ((4 + (b) * 2 + (h)) * HTB)
#define PG8_STAGE(bufoff, gbase, voff) do { _Pragma("unroll") for (int _i = 0; _i < 2; ++_i) \
        __builtin_amdgcn_global_load_lds((const unsigned*)((const char*)(gbase) + (voff)[_i]), (LAS unsigned*)(lds + (bufoff) + ldsw + _i * 8192), 16, 0, 0); } while (0)
#define PG8_LDA(dst, b, h) do { _Pragma("unroll") for (int m = 0; m < 4; ++m) _Pragma("unroll") for (int k = 0; k < 2; ++k) dst[m][k] = *(const LAS bf16x8*)(lds + PG8_SA(b, h) + aoff + m * 2048 + k * 1024); } while (0)
#define PG8_LDB(dst, b, h) do { _Pragma("unroll") for (int n = 0; n < 2; ++n) _Pragma("unroll") for (int k = 0; k < 2; ++k) dst[n][k] = *(const LAS bf16x8*)(lds + PG8_SB(b, h) + boff + n * 2048 + k * 1024); } while (0)
#define PG8_MMA(ai, bj, At, Bt) do { __builtin_amdgcn_s_setprio(1); _Pragma("unroll") for (int m = 0; m < 4; ++m) _Pragma("unroll") for (int n = 0; n < 2; ++n) _Pragma("unroll") for (int k = 0; k < 2; ++k) \
        acc[ai][bj][m][n] = __builtin_amdgcn_mfma_f32_16x16x32_bf16(Bt[n][k], At[m][k], acc[ai][bj][m][n], 0, 0, 0); __builtin_amdgcn_s_setprio(0); } while (0)
#define PG8_WAIT_V(n) asm volatile("s_waitcnt vmcnt(" #n ")" ::: "memory")
#define PG8_WAIT_L(n) asm volatile("s_waitcnt lgkmcnt(" #n ")" ::: "memory")
#define PG8_BAR __builtin_amdgcn_s_barrier()
#define PG8_SCHED __builtin_amdgcn_sched_barrier(0)
    Unit cur, nxt; int ui = 0;
    if (!S.next(0, cur)) return;
    f32x4 acc[2][2][4][2];
#pragma unroll
    for (int a = 0; a < 2; ++a)
#pragma unroll
        for (int b = 0; b < 2; ++b)
#pragma unroll
            for (int m = 0; m < 4; ++m)
#pragma unroll
                for (int n = 0; n < 2; ++n) acc[a][b][m][n] = (f32x4){0.f, 0.f, 0.f, 0.f};
    bf16x8 At[4][2], B0[2][2], B1[2][2];
    if constexpr (GATH) {
#pragma unroll
        for (int h_ = 0; h_ < 2; ++h_)
#pragma unroll
            for (int i = 0; i < 2; ++i) voffA[h_][i] = (unsigned)__hip_atomic_load(S.rowtok + cur.pm * BM + h_ * HALF + RA[i], __ATOMIC_RELAXED, __HIP_MEMORY_SCOPE_AGENT) * (unsigned)(g.lda * 2) + (unsigned)CA[i] * 2u; }
    const char* cA = (const char*)g.A + (GATH ? (size_t)0 : (size_t)cur.pm * tstepA); const char* cB = (const char*)g.Bt + (size_t)cur.pnb * tstepB;
    PG8_STAGE(PG8_SB(0, 0), cB, voffB); PG8_STAGE(PG8_SA(0, 0), cA, voffA[0]); PG8_STAGE(PG8_SB(0, 1), cB + hstepB, voffB); PG8_STAGE(PG8_SA(0, 1), cA, voffA[1]);
    if (wr == 1) PG8_BAR;
    PG8_WAIT_V(4); PG8_BAR;
    PG8_STAGE(PG8_SB(1, 0), cB + kstep, voffB); PG8_STAGE(PG8_SA(1, 0), cA + kstep, voffA[0]); PG8_STAGE(PG8_SB(1, 1), cB + hstepB + kstep, voffB);
    PG8_WAIT_V(6); PG8_BAR;
    for (;;) {
        const bool has_next = S.next(ui + 1, nxt);
        if constexpr (GATH) { if (has_next) {
#pragma unroll
            for (int h_ = 0; h_ < 2; ++h_)
#pragma unroll
                for (int i = 0; i < 2; ++i) voffN[h_][i] = (unsigned)__hip_atomic_load(S.rowtok + nxt.pm * BM + h_ * HALF + RA[i], __ATOMIC_RELAXED, __HIP_MEMORY_SCOPE_AGENT) * (unsigned)(g.lda * 2) + (unsigned)CA[i] * 2u; } }
        const char* nA = (has_next && !GATH) ? (const char*)g.A + (size_t)nxt.pm * tstepA : cA; const char* nB = has_next ? (const char*)g.Bt + (size_t)nxt.pnb * tstepB : cB;
        for (int t = 0; t < nt; t += 2) {
            const bool last = (t == nt - 2);
            const char* a1 = cA + PG8_KOFFA(t + 1);
            const char* b1 = cB + (size_t)(t + 1) * kstep; (void)b1;
            const char* a2 = last ? nA : cA + PG8_KOFFA(t + 2); const char* b2 = last ? nB : cB + (size_t)(t + 2) * kstep;
            const char* a3 = a2 + kstep; const char* b3 = b2 + kstep;
            unsigned vo0[2], vo1[2];
#pragma unroll
            for (int i = 0; i < 2; ++i) { vo0[i] = (GATH && last) ? voffN[0][i] : voffA[0][i]; vo1[i] = (GATH && last) ? voffN[1][i] : voffA[1][i]; }
            PG8_LDB(B0, 0, 0); PG8_SCHED; PG8_LDA(At, 0, 0); PG8_STAGE(PG8_SA(1, 1), a1, voffA[1]);
            PG8_WAIT_L(8); PG8_BAR; PG8_WAIT_L(0); PG8_MMA(0, 0, At, B0); PG8_BAR; PG8_SCHED;
            PG8_LDB(B1, 0, 1); PG8_STAGE(PG8_SB(0, 0), b2, voffB);
            PG8_BAR; PG8_WAIT_L(0); PG8_MMA(0, 1, At, B1); PG8_BAR;
            PG8_LDA(At, 0, 1); PG8_STAGE(PG8_SA(0, 0), a2, vo0);
            PG8_BAR; PG8_WAIT_L(0); PG8_MMA(1, 0, At, B0); PG8_BAR; PG8_SCHED;
            PG8_STAGE(PG8_SB(0, 1), b2 + hstepB, voffB);
            PG8_WAIT_V(6); PG8_BAR; PG8_MMA(1, 1, At, B1); PG8_BAR;
            PG8_LDB(B0, 1, 0); PG8_SCHED; PG8_LDA(At, 1, 0); PG8_STAGE(PG8_SA(0, 1), a2, vo1);
            PG8_WAIT_L(8); PG8_BAR; PG8_WAIT_L(0); PG8_MMA(0, 0, At, B0); PG8_BAR; PG8_SCHED;
            PG8_LDB(B1, 1, 1); PG8_STAGE(PG8_SB(1, 0), b3, voffB);
            PG8_BAR; PG8_WAIT_L(0); PG8_MMA(0, 1, At, B1); PG8_BAR;
            PG8_LDA(At, 1, 1); PG8_STAGE(PG8_SA(1, 0), a3, vo0);
            PG8_BAR; PG8_WAIT_L(0); PG8_MMA(1, 0, At, B0); PG8_BAR; PG8_SCHED;
            PG8_STAGE(PG8_SB(1, 1), b3 + hstepB, voffB);
            PG8_WAIT_V(6); PG8_BAR; PG8_MMA(1, 1, At, B1); PG8_BAR;
            if constexpr (SEG) { if (t == 6 || t == 14) E.rescale(acc, cur, t >> 3, wr, wc, fr, fq); }
        }
        E(acc, cur, wr, wc, fr, fq);
        if (!has_next) break;
#pragma unroll
        for (int a = 0; a < 2; ++a)
#pragma unroll
            for (int b = 0; b < 2; ++b)
#pragma unroll
                for (int m = 0; m < 4; ++m)
#pragma unroll
                    for (int n = 0; n < 2; ++n) acc[a][b][m][n] = (f32x4){0.f, 0.f, 0.f, 0.f};
        cur = nxt; cA = nA; cB = nB; ++ui;
        if constexpr (GATH) {
#pragma unroll
            for (int h_ = 0; h_ < 2; ++h_)
#pragma unroll
                for (int i = 0; i < 2; ++i) voffA[h_][i] = voffN[h_][i]; }
    }
    PG8_WAIT_V(0);
    if (wr == 0) PG8_BAR;
    PG8_BAR;
#undef PG8_KOFFA
#undef PG8_SA
#undef PG8_SB
#undef PG8_STAGE
#undef PG8_LDA
#undef PG8_LDB
#undef PG8_MMA
#undef PG8_WAIT_V
#undef PG8_WAIT_L
#undef PG8_BAR
#undef PG8_SCHED
}

template <int MAP, int ACT> struct EpiBlk {
    static constexpr bool PERM = true;
    bf16_t* pool;
    __device__ __forceinline__ int bmap(int pn) const {
        if (MAP == 0) return pn;
        if (MAP == 1) return BK_LW + pn;
        return pn < 4 ? pn : (pn < 10 ? pn + 2 : pn + 4);
    }
    __device__ __forceinline__ void operator()(const f32x4 (&acc)[2][2][4][2], const Unit& u, int wr, int wc, int fr, int fq) const {
        bf16_t* base = pool + (size_t)bmap(u.pn) * BLK_E;
        const int row0 = u.pm * BM + wr * 64 + fr, col0 = wc * 32 + 8 * fq;
#pragma unroll
        for (int ai = 0; ai < 2; ++ai)
#pragma unroll
            for (int m = 0; m < 4; ++m) { bf16_t* rowp = base + (size_t)(row0 + ai * HALF + m * 16) * 256 + col0;
#pragma unroll
                for (int bj = 0; bj < 2; ++bj) { f32x4 v0 = acc[ai][bj][m][0], v1 = acc[ai][bj][m][1];
                    if (ACT == 1) {
#pragma unroll
                        for (int j = 0; j < 4; ++j) { v0[j] = sigm(v0[j]); v1[j] = sigm(v1[j]); } }
                    u32x4 w; w.x = cvt_pk_bf16(v0[0], v0[1]); w.y = cvt_pk_bf16(v0[2], v0[3]); w.z = cvt_pk_bf16(v1[0], v1[1]); w.w = cvt_pk_bf16(v1[2], v1[3]);
                    *(u32x4*)(rowp + bj * HALF) = w; } }
    }
};
struct EpiRowBf16 {
    static constexpr bool PERM = true;
    bf16_t* O; int ldc;
    __device__ __forceinline__ void operator()(const f32x4 (&acc)[2][2][4][2], const Unit& u, int wr, int wc, int fr, int fq) const {
        const int row0 = u.pm * BM + wr * 64 + fr, col0 = u.pn * BM + wc * 32 + 8 * fq;
#pragma unroll
        for (int ai = 0; ai < 2; ++ai)
#pragma unroll
            for (int m = 0; m < 4; ++m) { bf16_t* rowp = O + (size_t)(row0 + ai * HALF + m * 16) * ldc + col0;
#pragma unroll
                for (int bj = 0; bj < 2; ++bj) { const f32x4 v0 = acc[ai][bj][m][0], v1 = acc[ai][bj][m][1];
                    u32x4 w; w.x = cvt_pk_bf16(v0[0], v0[1]); w.y = cvt_pk_bf16(v0[2], v0[3]); w.z = cvt_pk_bf16(v1[0], v1[1]); w.w = cvt_pk_bf16(v1[2], v1[3]);
                    *(u32x4*)(rowp + bj * HALF) = w; } }
    }
};
struct EpiSwiglu {
    static constexpr bool PERM = true;
    bf16_t* O;
    __device__ __forceinline__ void operator()(const f32x4 (&acc)[2][2][4][2], const Unit& u, int wr, int wc, int fr, int fq) const {
        const int row0 = u.pm * BM + wr * 64 + fr, col0 = u.pn * HALF + wc * 32 + 8 * fq;
#pragma unroll
        for (int ai = 0; ai < 2; ++ai)
#pragma unroll
            for (int m = 0; m < 4; ++m) { bf16_t* rowp = O + (size_t)(row0 + ai * HALF + m * 16) * DEXP + col0;
                f32x4 v0, v1;
#pragma unroll
                for (int j = 0; j < 4; ++j) { v0[j] = silu(acc[ai][0][m][0][j]) * acc[ai][1][m][0][j]; v1[j] = silu(acc[ai][0][m][1][j]) * acc[ai][1][m][1][j]; }
                u32x4 w; w.x = cvt_pk_bf16(v0[0], v0[1]); w.y = cvt_pk_bf16(v0[2], v0[3]); w.z = cvt_pk_bf16(v1[0], v1[1]); w.w = cvt_pk_bf16(v1[2], v1[3]);
                *(u32x4*)rowp = w; }
    }
};
template <int MODE> struct EpiBranch {
    static constexpr bool PERM = true;
    float* Y; const bf16_t* pool; bf16_t* yb; int gt0;
    __device__ __forceinline__ int gmap(int t) const { return t < 4 ? t : (t < 10 ? t + 2 : t + 4); }
    __device__ __forceinline__ void operator()(const f32x4 (&acc)[2][2][4][2], const Unit& u, int wr, int wc, int fr, int fq) const {
        const bf16_t* gbase = pool + (size_t)gmap(gt0 + u.pn) * BLK_E;
        const int row0 = u.pm * BM + wr * 64 + fr, colb = wc * 32 + 8 * fq;
#pragma unroll
        for (int ai = 0; ai < 2; ++ai)
#pragma unroll
            for (int m = 0; m < 4; ++m) { const size_t row = (size_t)(row0 + ai * HALF + m * 16);
#pragma unroll
                for (int bj = 0; bj < 2; ++bj) { const int cb = colb + bj * HALF;
                    const u32x4 gw = *(const u32x4*)(gbase + row * 256 + cb);
                    f32x4 g0, g1; g0[0] = bf2f(gw.x & 0xffffu); g0[1] = bf2f(gw.x >> 16); g0[2] = bf2f(gw.y & 0xffffu); g0[3] = bf2f(gw.y >> 16);
                    g1[0] = bf2f(gw.z & 0xffffu); g1[1] = bf2f(gw.z >> 16); g1[2] = bf2f(gw.w & 0xffffu); g1[3] = bf2f(gw.w >> 16);
                    float* yp = Y + row * D + u.pn * BM + cb;
                    f32x4 v0 = acc[ai][bj][m][0] * g0, v1 = acc[ai][bj][m][1] * g1;
                    if (MODE != 0) { v0 += *(const f32x4*)yp; v1 += *(const f32x4*)(yp + 4); }
                    if (MODE != 2) { *(f32x4*)yp = v0; *(f32x4*)(yp + 4) = v1; }
                    else { u32x4 w; w.x = cvt_pk_bf16(v0[0], v0[1]); w.y = cvt_pk_bf16(v0[2], v0[3]); w.z = cvt_pk_bf16(v1[0], v1[1]); w.w = cvt_pk_bf16(v1[2], v1[3]);
                        *(u32x4*)(yb + (size_t)u.pn * BLK_E + row * 256 + cb) = w; } } }
    }
};
struct EpiHorner {
    static constexpr bool PERM = true;
    const bf16_t* pool; bf16_t* yb;
    __device__ __forceinline__ int gmap(int t) const { return t < 4 ? t : (t < 10 ? t + 2 : t + 4); }
    __device__ __forceinline__ void rescale(f32x4 (&acc)[2][2][4][2], const Unit& u, int seg, int wr, int wc, int fr, int fq) const {
        const bf16_t* ga = pool + (size_t)gmap(seg * 4 + u.pn) * BLK_E; const bf16_t* gb = pool + (size_t)gmap(seg * 4 + 4 + u.pn) * BLK_E;
        const int row0 = u.pm * BM + wr * 64 + fr, colb = wc * 32 + 8 * fq;
#pragma unroll
        for (int ai = 0; ai < 2; ++ai)
#pragma unroll
            for (int m = 0; m < 4; ++m) { const size_t row = (size_t)(row0 + ai * HALF + m * 16);
#pragma unroll
                for (int bj = 0; bj < 2; ++bj) { const int cb = colb + bj * HALF;
                    const u32x4 wa = *(const u32x4*)(ga + row * 256 + cb), wb = *(const u32x4*)(gb + row * 256 + cb);
                    const unsigned ua[4] = {wa.x, wa.y, wa.z, wa.w}, ub[4] = {wb.x, wb.y, wb.z, wb.w};
#pragma unroll
                    for (int j = 0; j < 4; ++j) {
                        acc[ai][bj][m][0][j] *= bf2f((ua[j >> 1] >> ((j & 1) * 16)) & 0xffffu) * __builtin_amdgcn_rcpf(bf2f((ub[j >> 1] >> ((j & 1) * 16)) & 0xffffu));
                        acc[ai][bj][m][1][j] *= bf2f((ua[2 + (j >> 1)] >> ((j & 1) * 16)) & 0xffffu) * __builtin_amdgcn_rcpf(bf2f((ub[2 + (j >> 1)] >> ((j & 1) * 16)) & 0xffffu)); } } }
    }
    __device__ __forceinline__ void operator()(const f32x4 (&acc)[2][2][4][2], const Unit& u, int wr, int wc, int fr, int fq) const {
        const bf16_t* gc = pool + (size_t)gmap(8 + u.pn) * BLK_E;
        const int row0 = u.pm * BM + wr * 64 + fr, colb = wc * 32 + 8 * fq;
#pragma unroll
        for (int ai = 0; ai < 2; ++ai)
#pragma unroll
            for (int m = 0; m < 4; ++m) { const size_t row = (size_t)(row0 + ai * HALF + m * 16);
#pragma unroll
                for (int bj = 0; bj < 2; ++bj) { const int cb = colb + bj * HALF;
                    const u32x4 gw = *(const u32x4*)(gc + row * 256 + cb);
                    f32x4 g0, g1; g0[0] = bf2f(gw.x & 0xffffu); g0[1] = bf2f(gw.x >> 16); g0[2] = bf2f(gw.y & 0xffffu); g0[3] = bf2f(gw.y >> 16);
                    g1[0] = bf2f(gw.z & 0xffffu); g1[1] = bf2f(gw.z >> 16); g1[2] = bf2f(gw.w & 0xffffu); g1[3] = bf2f(gw.w >> 16);
                    const f32x4 v0 = acc[ai][bj][m][0] * g0, v1 = acc[ai][bj][m][1] * g1;
                    u32x4 w; w.x = cvt_pk_bf16(v0[0], v0[1]); w.y = cvt_pk_bf16(v0[2], v0[3]); w.z = cvt_pk_bf16(v1[0], v1[1]); w.w = cvt_pk_bf16(v1[2], v1[3]);
                    *(u32x4*)(yb + (size_t)u.pn * BLK_E + row * 256 + cb) = w; } }
    }
};
template <bool F32IN> struct EpiResid {
    static constexpr bool PERM = true;
    const float* xin32; bf16_t* xb; const float* gate;
    __device__ __forceinline__ void operator()(const f32x4 (&acc)[2][2][4][2], const Unit& u, int wr, int wc, int fr, int fq) const {
        const int row0 = u.pm * BM + wr * 64 + fr, col0 = u.pn * BM + wc * 32 + 8 * fq;
        const float* gp = gate + (size_t)(u.pm / 16) * 6144 + col0;
        f32x4 gv[2][2];
#pragma unroll
        for (int bj = 0; bj < 2; ++bj)
#pragma unroll
            for (int n = 0; n < 2; ++n) gv[bj][n] = *(const f32x4*)(gp + bj * HALF + 4 * n);
#pragma unroll
        for (int ai = 0; ai < 2; ++ai)
#pragma unroll
            for (int m = 0; m < 4; ++m) { const size_t row = (size_t)(row0 + ai * HALF + m * 16);
#pragma unroll
                for (int bj = 0; bj < 2; ++bj) { const int col = col0 + bj * HALF;
                    f32x4 x0, x1;
                    if (F32IN) { x0 = *(const f32x4*)(xin32 + row * D + col); x1 = *(const f32x4*)(xin32 + row * D + col + 4); }
                    else { const u32x4 w = *(const u32x4*)(xb + row * (2 * D) + col);
                        x0 = (f32x4){bf2f(w.x & 0xffffu), bf2f(w.x >> 16), bf2f(w.y & 0xffffu), bf2f(w.y >> 16)}; x1 = (f32x4){bf2f(w.z & 0xffffu), bf2f(w.z >> 16), bf2f(w.w & 0xffffu), bf2f(w.w >> 16)}; }
                    x0 += gv[bj][0] * acc[ai][bj][m][0]; x1 += gv[bj][1] * acc[ai][bj][m][1];
                    u32x4 o; o.x = cvt_pk_bf16(x0[0], x0[1]); o.y = cvt_pk_bf16(x0[2], x0[3]); o.z = cvt_pk_bf16(x1[0], x1[1]); o.w = cvt_pk_bf16(x1[2], x1[3]);
                    *(u32x4*)(xb + row * (2 * D) + col) = o; } }
    }
};
}

struct Args { const void* in[31]; float* out; unsigned char* ws; int ph_lo, ph_hi; };
enum { I_X = 0, I_C, I_POS, I_ADAW, I_ADAB, I_N1G, I_N2G, I_WIN, I_LBT, I_HGNW, I_MU, I_W0, I_W2, I_A0, I_A2, I_G2, I_KK, I_KA, I_RK, I_LNW, I_LNB,
       I_BRHG, I_BRRET, I_BRRW, I_WOUT, I_RG, I_RE, I_MW1, I_MW3, I_MW2, I_FG };
typedef const __attribute__((address_space(4))) Args KA;
#define FIN(i) ((const float*)a.in[i])
DEV bf16_t* pool_blk(KA& a, int blk) { return (bf16_t*)(a.ws + WS_POOL) + (size_t)blk * BLK_E; }

#define DPP_ADD(x, ctrl) x += __builtin_bit_cast(float, __builtin_amdgcn_update_dpp(__builtin_bit_cast(int, x), __builtin_bit_cast(int, x), ctrl, 0xF, 0xF, false))
DEV float row16_sum(float x) { DPP_ADD(x, 0xB1); DPP_ADD(x, 0x4E); DPP_ADD(x, 0x141); DPP_ADD(x, 0x140); return x; }
DEV float row8_sum(float x) { DPP_ADD(x, 0xB1); DPP_ADD(x, 0x4E); DPP_ADD(x, 0x141); return x; }

DEV void transpose_item(const float* W, int N, bf16_t* WT, int ldt, int dst_row0, LAS float* scr, int k0, int n0, int lane) {
#pragma unroll
    for (int i = 0; i < 8; ++i) { const int kk = 8 * i + (lane >> 3), n4 = (lane & 7) * 4;
        const f32x4 v = *(const f32x4*)(W + (size_t)(k0 + kk) * N + n0 + n4);
        scr[kk * 33 + n4] = v[0]; scr[kk * 33 + n4 + 1] = v[1]; scr[kk * 33 + n4 + 2] = v[2]; scr[kk * 33 + n4 + 3] = v[3]; }
    LDS_WAIT(); asm volatile("" ::: "memory");
    const int c = lane & 7;
#pragma unroll
    for (int j = 0; j < 4; ++j) { const int n = (lane >> 3) + 8 * j; const LAS float* s = scr + (8 * c) * 33 + n;
        u32x4 o; o.x = pk2(s[0 * 33], s[1 * 33]); o.y = pk2(s[2 * 33], s[3 * 33]); o.z = pk2(s[4 * 33], s[5 * 33]); o.w = pk2(s[6 * 33], s[7 * 33]);
        *(u32x4*)(WT + (size_t)(dst_row0 + n) * ldt + k0 + 8 * c) = o; }
    LDS_WAIT(); asm volatile("" ::: "memory");
}

DEV void phase_prologue(KA& a, LAS unsigned char* lds) {
    const int tid = opaque_tid(), lane = tid & 63, wave = tid >> 6, G = gridDim.x, wg = blockIdx.x;
    LAS float* scr = (LAS float*)(lds + wave * 8448);
    const int gw = wg * 8 + wave, NGW = G * 8;
    for (int it = gw; it < 2 * 5760; it += NGW) {
        const int l = it / 5760, r = it % 5760;
        if (r < 4480) { const int kb = r / 280, nb = r % 280;
            transpose_item(FIN(I_WIN) + (size_t)l * 1024 * INC, INC, (bf16_t*)(a.ws + WS_WIN) + (size_t)l * INC * 1024, 1024, nb * 32, scr, kb * 64, nb * 32, lane); }
        else if (r < 4480 + 768) { const int r2 = r - 4480, br = r2 / 256, r3 = r2 % 256, kb = r3 / 32, nb = r3 % 32;
            const float* W = (br == 0 ? FIN(I_BRHG) : (br == 1 ? FIN(I_BRRET) : FIN(I_BRRW))) + (size_t)l * 512 * 1024;
            transpose_item(W, 1024, (bf16_t*)(a.ws + WS_BR) + (size_t)l * 1024 * 1536 + br * 512, 1536, nb * 32, scr, kb * 64, nb * 32, lane); }
        else { const int r4 = r - 5248, kb = r4 / 32, nb = r4 % 32;
            transpose_item(FIN(I_WOUT) + (size_t)l * 1024 * 1024, 1024, (bf16_t*)(a.ws + WS_WOUT) + (size_t)l * 1024 * 1024, 1024, nb * 32, scr, kb * 64, nb * 32, lane); }
    }
    {
        unsigned* LB = (unsigned*)(a.ws + WS_LORAB);
        for (int p = wg * 512 + tid; p < 2 * 1536 * 128; p += G * 512) {
            const int l = p / (1536 * 128), rem = p % (1536 * 128), n = rem / 128, k = (rem % 128) * 2;
            float v0 = 0.f, v1 = 0.f;
            if (n < 512) { if (k < 64) { v0 = FIN(I_W2)[((size_t)l * 64 + k) * 512 + n]; v1 = FIN(I_W2)[((size_t)l * 64 + k + 1) * 512 + n]; } }
            else if (n < 1024) { if (k >= 64 && k < 128) { v0 = FIN(I_A2)[((size_t)l * 64 + k - 64) * 512 + n - 512]; v1 = FIN(I_A2)[((size_t)l * 64 + k - 63) * 512 + n - 512]; } }
            else { if (k >= 128) { v0 = FIN(I_G2)[((size_t)l * 128 + k - 128) * 512 + n - 1024]; v1 = FIN(I_G2)[((size_t)l * 128 + k - 127) * 512 + n - 1024]; } }
            LB[p] = pk2(v0, v1);
        }
    }
    if (wg == 0) {
        float* LBv = (float*)(a.ws + WS_LB);
        for (int i = tid; i < 512; i += 512) { const float t0 = FIN(I_LBT)[i], t1 = FIN(I_LBT)[512 + i]; LBv[i] = 0.f; LBv[512 + i] = 1.f / (1.f + __expf(t0 - t1)); }
    }
    __syncthreads();
    {
        LAS float* cond = (LAS float*)lds;
        LAS float* red = (LAS float*)(lds + 4096);
        float* modp = (float*)(a.ws + WS_MODP);
        for (int item = wg; item < 384; item += G) {
            const int l = item / 192, s = (item % 192) / 24, cb = item % 24;
            for (int i = tid; i < 1024; i += 512) { const int b = i >> 7, kk = i & 127; cond[i] = silu(FIN(I_C)[b * 1024 + s * 128 + kk]); }
            __syncthreads();
            const int colin = tid & 255, half = tid >> 8, col = cb * 256 + colin;
            float acc[8];
#pragma unroll
            for (int b = 0; b < 8; ++b) acc[b] = 0.f;
            const float* Wp = FIN(I_ADAW) + ((size_t)l * 1024 + s * 128 + half * 64) * 6144 + col;
#pragma unroll 16
            for (int kk = 0; kk < 64; ++kk) { const float w = Wp[(size_t)kk * 6144];
#pragma unroll
                for (int b = 0; b < 8; ++b) acc[b] += cond[b * 128 + half * 64 + kk] * w; }
            if (half == 1) {
#pragma unroll
                for (int b = 0; b < 8; ++b) red[b * 256 + colin] = acc[b]; }
            __syncthreads();
            if (half == 0) {
#pragma unroll
                for (int b = 0; b < 8; ++b) modp[((size_t)(s * 2 + l) * 8 + b) * 6144 + col] = acc[b] + red[b * 256 + colin]; }
            __syncthreads();
        }
    }
}

template <int MODE> DEV void phase_norm(KA& a, LAS unsigned char* lds, int l) {
    const int tid = opaque_tid(), lane = tid & 63, wave = tid >> 6, G = gridDim.x, wg = blockIdx.x;
    LAS float* sc = (LAS float*)lds; LAS float* sh = sc + 1024; LAS float* gn = sc + 2048;
    LAS float* g2 = sc + 3072;
    LAS float* Wr = sc + 3072;
    LAS int* hist = (LAS int*)(lds + 12288 + 147456);
    const float* modp = (const float*)(a.ws + WS_MODP);
    float* mod = (float*)(a.ws + WS_MOD);
    if (MODE == 0) {
        for (int i = wg * 512 + tid; i < 2 * 8 * 6144; i += G * 512) { const int ll = i / (8 * 6144), rem = i % (8 * 6144), b = rem / 6144, j = rem % 6144;
            float s = FIN(I_ADAB)[ll * 6144 + j];
#pragma unroll
            for (int k = 0; k < 8; ++k) s += modp[((size_t)(k * 2 + ll) * 8 + b) * 6144 + j];
            mod[i] = s; }
    }
    if (MODE == 2) {
        LAS float* scr = (LAS float*)(lds + wave * 8448);
        const int gw = wg * 8 + wave, NGW = G * 8;
        bf16_t* W13T = (bf16_t*)(a.ws + WS_POOL + PO_W13); bf16_t* W2T = (bf16_t*)(a.ws + WS_POOL + PO_W2);
        for (int it = gw; it < NEXP * 768; it += NGW) {
            const int e = it / 768, r = it % 768;
            if (r < 512) { const int w3 = r / 256, r2 = r % 256, kb = r2 / 16, nb = r2 % 16, n0 = nb * 32;
                const float* W = (w3 ? FIN(I_MW3) : FIN(I_MW1)) + ((size_t)l * NEXP + e) * 1024 * 512;
                transpose_item(W, 512, W13T + (size_t)e * 1024 * 1024, 1024, (n0 / 128) * 256 + w3 * 128 + (n0 % 128), scr, kb * 64, n0, lane); }
            else { const int r2 = r - 512, kb = r2 / 32, nb = r2 % 32;
                transpose_item(FIN(I_MW2) + ((size_t)l * NEXP + e) * 512 * 1024, 1024, W2T + (size_t)e * 1024 * 512, 512, nb * 32, scr, kb * 64, nb * 32, lane); }
        }
        __syncthreads();
        for (int i = tid; i < 1024 * 4; i += 512) { const int k = i >> 2, o = i & 3; Wr[o * 1024 + k] = FIN(I_RG)[(size_t)l * 4096 + i]; }
        for (int i = tid; i < 1024 * 32; i += 512) { const int k = i >> 5, o = i & 31; Wr[(4 + o) * 1024 + k] = FIN(I_RE)[(size_t)l * 32768 + i]; }
        if (tid < 32) hist[tid] = 0;
    }
    const float* xsrc = (MODE == 0) ? FIN(I_X) : a.out;
    const bf16_t* Y2 = (const bf16_t*)(a.ws + WS_POOL + PO_Y2);
    const int* selp = (const int*)(a.ws + WS_SEL_P); const float* selw = (const float*)(a.ws + WS_SEL_W);
    bf16_t* H = (bf16_t*)(a.ws + WS_H);
    for (int grp = wg; grp < NTOK / 128; grp += G) {
        const int b = grp / 32;
        __syncthreads();
        for (int j = tid; j < 1024; j += 512) {
            float scale, shift, gain;
            if (MODE == 0) { float s0 = FIN(I_ADAB)[l * 6144 + j], s1 = FIN(I_ADAB)[l * 6144 + 1024 + j];
#pragma unroll
                for (int k = 0; k < 8; ++k) { s0 += modp[((size_t)(k * 2 + l) * 8 + b) * 6144 + j]; s1 += modp[((size_t)(k * 2 + l) * 8 + b) * 6144 + 1024 + j]; }
                shift = s0; scale = s1; gain = FIN(I_N1G)[l * 1024 + j]; }
            else if (MODE == 1) { shift = mod[((size_t)l * 8 + b) * 6144 + j]; scale = mod[((size_t)l * 8 + b) * 6144 + 1024 + j]; gain = FIN(I_N1G)[l * 1024 + j]; }
            else if (MODE == 2) { shift = mod[((size_t)l * 8 + b) * 6144 + 3072 + j]; scale = mod[((size_t)l * 8 + b) * 6144 + 4096 + j]; gain = FIN(I_N2G)[l * 1024 + j]; }
            else { shift = 0.f; scale = 0.f; gain = FIN(I_FG)[j]; }
            sc[j] = 1.f + scale; sh[j] = shift; gn[j] = gain;
            if (MODE == 1 || MODE == 3) { const int lp = (MODE == 1) ? l - 1 : DEPTH - 1; g2[j] = mod[((size_t)lp * 8 + b) * 6144 + 5120 + j]; }
        }
        __syncthreads();
        const bf16_t* xb = (const bf16_t*)a.out;
#define LOADX(dst, n_) do { if (MODE == 0) { _Pragma("unroll") for (int j = 0; j < 4; ++j) dst[j] = *(const f32x4*)(xsrc + (size_t)(n_) * D + 256 * j + 4 * lane); } \
            else { _Pragma("unroll") for (int j = 0; j < 4; ++j) { const u32x2 w_ = *(const u32x2*)(xb + (size_t)(n_) * (2 * D) + 256 * j + 4 * lane); \
                dst[j] = (f32x4){bf2f(w_.x & 0xffffu), bf2f(w_.x >> 16), bf2f(w_.y & 0xffffu), bf2f(w_.y >> 16)}; } } } while (0)
        constexpr int NBT = (MODE == 2) ? 4 : ((MODE == 0) ? 4 : 2);
        for (int tb = 0; tb < 16; tb += NBT) {
        f32x4 vb_[NBT][4]; int pb0[NBT] = {}, pb1[NBT] = {}; float wb0[NBT] = {}, wb1[NBT] = {}; u32x2 yb0[NBT][4], yb1[NBT][4];
#pragma unroll
        for (int u = 0; u < NBT; ++u) { const int n_ = grp * 128 + wave * 16 + tb + u; LOADX(vb_[u], n_);
            if (MODE == 1 || MODE == 3) { pb0[u] = ld_vec_i(selp + 2 * n_); pb1[u] = ld_vec_i(selp + 2 * n_ + 1); wb0[u] = ld_vec_f(selw + 2 * n_); wb1[u] = ld_vec_f(selw + 2 * n_ + 1); } }
        if (MODE == 1 || MODE == 3) {
#pragma unroll
            for (int u = 0; u < NBT; ++u)
#pragma unroll
                for (int j = 0; j < 4; ++j) { const int c = 256 * j + 4 * lane; yb0[u][j] = *(const u32x2*)(Y2 + (size_t)pb0[u] * D + c); yb1[u][j] = *(const u32x2*)(Y2 + (size_t)pb1[u] * D + c); } }
#pragma unroll
        for (int u = 0; u < NBT; ++u) {
            const int ti = tb + u; (void)ti;
            const int n = grp * 128 + wave * 16 + tb + u;
            f32x4 v[4];
#pragma unroll
            for (int j = 0; j < 4; ++j) v[j] = vb_[u][j];
            if (MODE == 1 || MODE == 3) {
                const float w0 = wb0[u], w1 = wb1[u];
#pragma unroll
                for (int j = 0; j < 4; ++j) { const int c = 256 * j + 4 * lane;
                    const u32x2 y0 = yb0[u][j], y1 = yb1[u][j];
                    const f32x4 gg = *(const LAS f32x4*)(g2 + c);
                    v[j][0] += gg[0] * (w0 * bf2f(y0.x & 0xffffu) + w1 * bf2f(y1.x & 0xffffu));
                    v[j][1] += gg[1] * (w0 * bf2f(y0.x >> 16) + w1 * bf2f(y1.x >> 16));
                    v[j][2] += gg[2] * (w0 * bf2f(y0.y & 0xffffu) + w1 * bf2f(y1.y & 0xffffu));
                    v[j][3] += gg[3] * (w0 * bf2f(y0.y >> 16) + w1 * bf2f(y1.y >> 16));
                    if (MODE == 1) { u32x2 o_; o_.x = pk2(v[j][0], v[j][1]); o_.y = pk2(v[j][2], v[j][3]); *(u32x2*)((bf16_t*)a.out + (size_t)n * (2 * D) + c) = o_; } }
            }
            float ss = 0.f;
#pragma unroll
            for (int j = 0; j < 4; ++j) ss += (v[j][0] * v[j][0] + v[j][1] * v[j][1]) + (v[j][2] * v[j][2] + v[j][3] * v[j][3]);
            ss = wave_sum(ss);
            const float r = __builtin_amdgcn_rsqf(ss * (1.f / D) + NORM_EPS);
#pragma unroll
            for (int j = 0; j < 4; ++j) { const int c = 256 * j + 4 * lane;
                const f32x4 gg = *(const LAS f32x4*)(gn + c), s1 = *(const LAS f32x4*)(sc + c), s0 = *(const LAS f32x4*)(sh + c);
                v[j] = v[j] * r * gg * s1 + s0;
                if (MODE == 3) *(f32x4*)(a.out + (size_t)n * D + c) = v[j];
                else { u32x2 o; o.x = pk2(v[j][0], v[j][1]); o.y = pk2(v[j][2], v[j][3]); *(u32x2*)(H + (size_t)n * D + c) = o; } }
            if (MODE == 2) {
#define RT_RED(X, N_) do { \
                _Pragma("unroll") for (int o = 0; o < N_; ++o) X[o] += __builtin_bit_cast(float, __builtin_amdgcn_update_dpp(0, __builtin_bit_cast(int, X[o]), 0xB1, 0xF, 0xF, true)); \
                _Pragma("unroll") for (int o = 0; o < N_; ++o) X[o] += __builtin_bit_cast(float, __builtin_amdgcn_update_dpp(0, __builtin_bit_cast(int, X[o]), 0x4E, 0xF, 0xF, true)); \
                _Pragma("unroll") for (int o = 0; o < N_; ++o) X[o] += __builtin_bit_cast(float, __builtin_amdgcn_update_dpp(0, __builtin_bit_cast(int, X[o]), 0x141, 0xF, 0xF, true)); \
                _Pragma("unroll") for (int o = 0; o < N_; ++o) X[o] += __builtin_bit_cast(float, __builtin_amdgcn_update_dpp(0, __builtin_bit_cast(int, X[o]), 0x140, 0xF, 0xF, true)); \
                _Pragma("unroll") for (int o = 0; o < N_; ++o) X[o] += __builtin_bit_cast(float, __builtin_amdgcn_update_dpp(0, __builtin_bit_cast(int, X[o]), 0x142, 0xA, 0xF, false)); \
                _Pragma("unroll") for (int o = 0; o < N_; ++o) X[o] += __builtin_bit_cast(float, __builtin_amdgcn_update_dpp(0, __builtin_bit_cast(int, X[o]), 0x143, 0xC, 0xF, false)); \
                _Pragma("unroll") for (int o = 0; o < N_; ++o) X[o] = __builtin_bit_cast(float, __builtin_amdgcn_readlane(__builtin_bit_cast(int, X[o]), 63)); } while (0)
                float L[4];
#pragma unroll
                for (int o = 0; o < 4; ++o) { float p = 0.f;
#pragma unroll
                    for (int j = 0; j < 4; ++j) { const f32x4 w = *(const LAS f32x4*)(Wr + o * 1024 + 256 * j + 4 * lane); p += (v[j][0] * w[0] + v[j][1] * w[1]) + (v[j][2] * w[2] + v[j][3] * w[3]); }
                    L[o] = p; }
                RT_RED(L, 4);
                int gi = 0; float gm = L[0];
#pragma unroll
                for (int o = 1; o < 4; ++o) if (L[o] > gm) { gm = L[o]; gi = o; }
                float gs = 0.f;
#pragma unroll
                for (int o = 0; o < 4; ++o) gs += __expf(L[o] - gm);
                const float gw_ = 1.f / gs;
                float le[8];
                { const LAS float* We = Wr + (4 + gi * 8) * 1024;
#pragma unroll
                  for (int o = 0; o < 8; ++o) { float p = 0.f;
#pragma unroll
                    for (int j = 0; j < 4; ++j) { const f32x4 w = *(const LAS f32x4*)(We + o * 1024 + 256 * j + 4 * lane); p += (v[j][0] * w[0] + v[j][1] * w[1]) + (v[j][2] * w[2] + v[j][3] * w[3]); }
                    le[o] = p; } }
                RT_RED(le, 8);
#undef RT_RED
                int i0 = 0; float m0 = le[0];
#pragma unroll
                for (int j = 1; j < 8; ++j) if (le[j] > m0) { m0 = le[j]; i0 = j; }
                int i1 = -1; float m1 = -3.0e38f;
#pragma unroll
                for (int j = 0; j < 8; ++j) if (j != i0 && le[j] > m1) { m1 = le[j]; i1 = j; }
                const float e1 = __expf(m1 - m0), den = 1.f / (1.f + e1);
                if (lane == 0) {
                    int* sele = (int*)(a.ws + WS_SEL_E); float* selwv = (float*)(a.ws + WS_SEL_W);
                    sele[2 * n] = gi * 8 + i0; sele[2 * n + 1] = gi * 8 + i1;
                    selwv[2 * n] = gw_ * den; selwv[2 * n + 1] = gw_ * e1 * den;
                    __hip_atomic_fetch_add(hist + gi * 8 + i0, 1, __ATOMIC_RELAXED, __HIP_MEMORY_SCOPE_WORKGROUP); __hip_atomic_fetch_add(hist + gi * 8 + i1, 1, __ATOMIC_RELAXED, __HIP_MEMORY_SCOPE_WORKGROUP);
                }
            }
        }
        }
        if (MODE == 2) {
            __syncthreads();
            if (tid < 32) { ((int*)(a.ws + WS_CNT))[grp * 32 + tid] = hist[tid]; hist[tid] = 0; }
        }
    }
}

DEV void unpack8(const u32x4 w, float (&f)[8]) { f[0] = bf2f(w.x & 0xffffu); f[1] = bf2f(w.x >> 16); f[2] = bf2f(w.y & 0xffffu); f[3] = bf2f(w.y >> 16);
    f[4] = bf2f(w.z & 0xffffu); f[5] = bf2f(w.z >> 16); f[6] = bf2f(w.w & 0xffffu); f[7] = bf2f(w.w >> 16); }
DEV u32x4 pack8(const float (&f)[8]) { u32x4 w; w.x = pk2(f[0], f[1]); w.y = pk2(f[2], f[3]); w.z = pk2(f[4], f[5]); w.w = pk2(f[6], f[7]); return w; }
DEV void phase_mpre(KA& a, LAS unsigned char* lds, int l, const bool dum = false) {
    const int tid = opaque_tid(), G = gridDim.x, wg = blockIdx.x;
    {
        LAS float* gt = (LAS float*)lds;
        const float* lbv = (const float*)(a.ws + WS_LB) + l * 512;
        float* side = (float*)(a.ws + WS_HGSIDE);
        const int sub = tid >> 8, tg = (tid >> 6) & 3, dp = tid & 63, d = 2 * dp;
        for (int slot = wg; slot < NB * 64 * 2; slot += G) {
            const int item = slot * 2 + sub, b = item >> 8, c = (item >> 2) & 63, h = item & 3;
            bf16_t* zq = pool_blk(a, BK_HGQ + (h >> 1)) + (h & 1) * 128 + d;
            bf16_t* zf = pool_blk(a, BK_HGF + (h >> 1)) + (h & 1) * 128 + d;
            const size_t n0 = (size_t)b * T + c * 64 + tg * 16;
            const float lb0 = lbv[h * 128 + d], lb1 = lbv[h * 128 + d + 1];
            float qv[16][2], kv[16][2], pc[16][2]; float run0 = 0.f, run1 = 0.f;
#pragma unroll
            for (int i = 0; i < 16; ++i) { const unsigned wq = *(const unsigned*)(zq + (n0 + i) * 256), wf = *(const unsigned*)(zf + (n0 + i) * 256);
                const float f0 = lb0 + (1.f - lb0) * sigm(bf2f(wf & 0xffffu)), f1 = lb1 + (1.f - lb1) * sigm(bf2f(wf >> 16));
                qv[i][0] = silu(bf2f(wq & 0xffffu)) * 0.08838834764831845f; qv[i][1] = silu(bf2f(wq >> 16)) * 0.08838834764831845f;
                kv[i][0] = 1.f - f0; kv[i][1] = 1.f - f1;
                run0 += __logf(fmaxf(f0, 1e-30f)); run1 += __logf(fmaxf(f1, 1e-30f)); pc[i][0] = run0; pc[i][1] = run1; }
            __syncthreads();
            *(LAS f32x2*)(gt + (sub * 4 + tg) * 128 + d) = (f32x2){run0, run1};
            __syncthreads();
            const f32x2 g0 = *(const LAS f32x2*)(gt + (sub * 4 + 0) * 128 + d), g1 = *(const LAS f32x2*)(gt + (sub * 4 + 1) * 128 + d), g2_ = *(const LAS f32x2*)(gt + (sub * 4 + 2) * 128 + d), g3 = *(const LAS f32x2*)(gt + (sub * 4 + 3) * 128 + d);
            const f32x2 ref = g0 + g1, tot = ref + g2_ + g3;
            const f32x2 off = tg == 0 ? (f32x2){0.f, 0.f} : (tg == 1 ? g0 : (tg == 2 ? ref : ref + g2_));
#pragma unroll
            for (int i = 0; i < 16; ++i) { const float c0_ = off[0] + pc[i][0], c1_ = off[1] + pc[i][1];
                *(unsigned*)((dum ? zq + 28 * BLK_E : zq) + (n0 + i) * 256) = pk2(qv[i][0] * __expf(c0_ - ref[0]), qv[i][1] * __expf(c1_ - ref[1]));
                *(unsigned*)((dum ? zf + 28 * BLK_E : zf) + (n0 + i) * 256) = pk2(kv[i][0] * __expf(ref[0] - c0_), kv[i][1] * __expf(ref[1] - c1_)); }
            if (tg == 0) { float* sp = side + ((size_t)(b * 64 + c) * 4 + h) * 384 + d;
                *(f32x2*)sp = (f32x2){__expf(ref[0]), __expf(ref[1])}; *(f32x2*)(sp + 128) = (f32x2){__expf(tot[0]), __expf(tot[1])}; *(f32x2*)(sp + 256) = (f32x2){__expf(tot[0] - ref[0]), __expf(tot[1] - ref[1])}; }
        }
    }
    const int* pos = (const int*)a.in[I_POS];
    for (int p = wg * 512 + tid; p < NTOK * 32; p += G * 512) {
        const int n = p >> 5, h = (p >> 3) & 3, g = p & 7;
        const float fp = (float)pos[n];
        float sn[8], cs[8];
#pragma unroll
        for (int j = 0; j < 8; ++j) { const int i = g * 8 + j; const float invf = exp2f(-(float)(2 * i) * (13.287712379549449f / 128.f));
            float rev = fp * invf * 0.15915494309189535f; rev -= floorf(rev); sn[j] = __builtin_amdgcn_sinf(rev); cs[j] = __builtin_amdgcn_cosf(rev); }
        const size_t off = (size_t)n * 256 + (h & 1) * 128 + g * 8;
        bf16_t* q = pool_blk(a, BK_RTQ + (h >> 1)) + off; bf16_t* k = pool_blk(a, BK_RTK + (h >> 1)) + off;
        float q1[8], q2[8], k1[8], k2[8], o1[8], o2[8];
        unpack8(*(const u32x4*)q, q1); unpack8(*(const u32x4*)(q + 64), q2); unpack8(*(const u32x4*)k, k1); unpack8(*(const u32x4*)(k + 64), k2);
        bf16_t* qo = dum ? q + 16 * BLK_E : q; bf16_t* ko = dum ? k + 16 * BLK_E : k;
        const float sc_ = 0.08838834764831845f;
#pragma unroll
        for (int j = 0; j < 8; ++j) { o1[j] = (q1[j] * cs[j] - q2[j] * sn[j]) * sc_; o2[j] = (q1[j] * sn[j] + q2[j] * cs[j]) * sc_; }
        *(u32x4*)qo = pack8(o1); *(u32x4*)(qo + 64) = pack8(o2);
#pragma unroll
        for (int j = 0; j < 8; ++j) { o1[j] = k1[j] * cs[j] - k2[j] * sn[j]; o2[j] = k1[j] * sn[j] + k2[j] * cs[j]; }
        *(u32x4*)ko = pack8(o1); *(u32x4*)(ko + 64) = pack8(o2);
    }
    const bf16_t* zl = pool_blk(a, BK_RWL); bf16_t* ap = pool_blk(a, BK_LIN);
    const float* mu = FIN(I_MU) + (size_t)l * 1792 + 1536;
    for (int p = wg * 512 + tid; p < NTOK * 32; p += G * 512) {
        const int n = p >> 5, c0 = (p & 31) * 8, t = n & (T - 1);
        float raw[8], prev[8], o[8];
        unpack8(*(const u32x4*)(zl + (size_t)n * 256 + c0), raw);
        if (t > 0) unpack8(*(const u32x4*)(zl + (size_t)(n - 1) * 256 + c0), prev);
        else {
#pragma unroll
            for (int j = 0; j < 8; ++j) prev[j] = 0.f; }
#pragma unroll
        for (int j = 0; j < 8; ++j) { const float zs = raw[j] + mu[c0 + j] * (prev[j] - raw[j]);
            o[j] = c0 < 64 ? tanhf(zs) : (c0 < 128 ? zs : sigm(zs)); }
        *(u32x4*)(ap + (size_t)n * 256 + c0) = pack8(o);
    }
}


DEV void phase_scan_chunk(KA& a, LAS unsigned char* lds, int l, const bool dum = false) {
    const int tid = opaque_tid(), lane = tid & 63, wave = tid >> 6, G = gridDim.x, wg = blockIdx.x;
    constexpr int SQ = 272, SK = 144;
    constexpr int O_QE = 0, O_KE = 17408, O_KT = 34816, O_VT = 53248, BUFSZ = 57856;
    constexpr int O_ST = 2 * BUFSZ, STSZ = 8704, O_P = O_ST + 2 * STSZ, PSZ = 9216;
    static_assert(O_P + PSZ <= LDS_MISC, "LDS map");
    const int fr = lane & 15, fq = lane >> 4;
    const int ti = wave >> 1, vi = wave & 1;
    const float* side = (const float*)(a.ws + WS_HGSIDE);
    for (int it0 = wg; it0 < 256; it0 += G) {
        const int item = (G == 256) ? (((it0 & 7) * 8 + (it0 >> 5)) * 4 + ((it0 >> 3) & 3)) : it0;
        const int type = item >> 7, b = (item >> 4) & 7, h = (item >> 2) & 3, j = item & 3;
        const bf16_t* gq = pool_blk(a, (type ? BK_RTQ : BK_HGQ) + (h >> 1)) + (h & 1) * 128;
        const bf16_t* gk = pool_blk(a, (type ? BK_RTK : BK_HGF) + (h >> 1)) + (h & 1) * 128;
        bf16_t* gv = pool_blk(a, (type ? BK_RTV : BK_HGI) + (h >> 1)) + (h & 1) * 128 + j * 32;
        bf16_t* go = dum ? pool_blk(a, 30 + (h >> 1)) + (h & 1) * 128 + j * 32 : gv;
        const float lg2g = log2f(1.f - exp2f(-5.f - (float)h));
        const float g64 = exp2f(64.f * lg2g);
        __syncthreads();
        for (int i = tid; i < (2 * STSZ + PSZ) / 4; i += 512) ((LAS unsigned*)(lds + O_ST))[i] = 0u;
        u32x4 rqA[2], rkA[2], rvA[2], rqB[2], rkB[2], rvB[2];
        f32x4 S0 = (f32x4){0.f, 0.f, 0.f, 0.f}, S1 = S0;
        const int rp = tid >> 4, ch = tid & 15, rpv = (tid >> 2) & 31, chv = tid & 3;
        const float zs0 = type ? exp2f((float)(63 - 2 * rp) * lg2g) : 1.f, zs1 = type ? exp2f((float)(62 - 2 * rp) * lg2g) : 1.f;
        float mk[2][4], rsc[4];
#pragma unroll
        for (int q = 0; q < 2; ++q)
#pragma unroll
            for (int r = 0; r < 4; ++r) { const int t = 16 * ti + 4 * fq + r, s_ = 16 * (2 * (wave & 1) + q) + fr; mk[q][r] = (t >= s_) ? (type ? exp2f((float)(t - s_) * lg2g) : 1.f) : 0.f; }
#pragma unroll
        for (int r = 0; r < 4; ++r) rsc[r] = type ? exp2f((float)(16 * ti + 4 * fq + r + 1) * lg2g) : 1.f;
#define SC_LOAD(RQ, RK_, RV, cc) do { const size_t n0_ = (size_t)b * T + (size_t)(cc) * 64; \
            _Pragma("unroll") for (int i = 0; i < 2; ++i) { RQ[i] = *(const u32x4*)(gq + (n0_ + 2 * rp + i) * 256 + ch * 8); RK_[i] = *(const u32x4*)(gk + (n0_ + 2 * rp + i) * 256 + ch * 8); } \
            if (tid < 128) { _Pragma("unroll") for (int i = 0; i < 2; ++i) RV[i] = *(const u32x4*)(gv + (n0_ + 2 * rpv + i) * 256 + chv * 8); } } while (0)
#define SC_WRITE(RQ, RK_, RV, pb) do { LAS unsigned char* B_ = lds + (pb) * BUFSZ; \
            _Pragma("unroll") for (int i = 0; i < 2; ++i) { *(LAS u32x4*)(B_ + O_QE + (2 * rp + i) * SQ + ch * 16) = RQ[i]; *(LAS u32x4*)(B_ + O_KE + (2 * rp + i) * SQ + ch * 16) = RK_[i]; } \
            { float k0[8], k1[8]; unpack8(RK_[0], k0); unpack8(RK_[1], k1); \
              _Pragma("unroll") for (int e = 0; e < 8; ++e) *(LAS unsigned*)(B_ + O_KT + (ch * 8 + e) * SK + (((rp >> 2) ^ (ch & 7)) * 16) + (rp & 3) * 4) = pk2(k0[e] * zs0, k1[e] * zs1); } \
            if (tid < 128) { const unsigned w0_[4] = {RV[0].x, RV[0].y, RV[0].z, RV[0].w}, w1_[4] = {RV[1].x, RV[1].y, RV[1].z, RV[1].w}; \
                _Pragma("unroll") for (int e = 0; e < 8; ++e) { const unsigned lo_ = (w0_[e >> 1] >> ((e & 1) * 16)) & 0xffffu, hi_ = (w1_[e >> 1] >> ((e & 1) * 16)) & 0xffffu; \
                    *(LAS unsigned*)(B_ + O_VT + (chv * 8 + e) * SK + (((rpv >> 2) ^ chv) * 16) + (rpv & 3) * 4) = lo_ | (hi_ << 16); } } } while (0)
#define SC_KT(row, kc) (O_KT + (row) * SK + ((((kc)) ^ (((row) >> 3) & 7)) * 16))
#define SC_VT(row, kc) (O_VT + (row) * SK + ((((kc)) ^ (((row) >> 3) & 3)) * 16))
#define SC_SIDE(A_, B_, E_, cc) do { _Pragma("unroll") for (int q = 0; q < 2; ++q) { const int d = 16 * (2 * (wave >> 1) + q) + fr; \
            if (type == 0 && (cc) < 64) { const float* sp = side + ((size_t)(b * 64 + (cc)) * 4 + h) * 384 + d; A_[q] = sp[128]; B_[q] = sp[256]; E_[q] = ((cc) + 1 < 64) ? sp[4 * 384] : 1.f; } \
            else { A_[q] = g64; B_[q] = 1.f; E_[q] = 1.f; } } } while (0)
#define SC_BODY(c, pb, LQ, LK, LV, WQ, WK, WV) do { \
            LAS unsigned char* B = lds + (pb) * BUFSZ; \
            const size_t n0 = (size_t)b * T + (size_t)(c) * 64; \
            SC_SIDE(na, nb, ne, (c) + 1);     \
            if ((c) + 2 < 64) SC_LOAD(LQ, LK, LV, (c) + 2); \
            _Pragma("unroll") for (int q = 0; q < 2; ++q) { const int si = 2 * (wave & 1) + q; \
                if (si <= ti) { \
                    f32x4 acc = (f32x4){0.f, 0.f, 0.f, 0.f}; \
                    _Pragma("unroll") for (int kk = 0; kk < 4; ++kk) { const bf16x8 af = *(const LAS bf16x8*)(B + O_QE + (16 * ti + fr) * SQ + (32 * kk + 8 * fq) * 2); \
                        const bf16x8 bf = *(const LAS bf16x8*)(B + O_KE + (16 * si + fr) * SQ + (32 * kk + 8 * fq) * 2); \
                        acc = __builtin_amdgcn_mfma_f32_16x16x32_bf16(af, bf, acc, 0, 0, 0); } \
                    _Pragma("unroll") for (int r = 0; r < 4; ++r) { const int t = 16 * ti + 4 * fq + r, s_ = 16 * si + fr; \
                        *(LAS bf16_t*)(lds + O_P + t * SK + s_ * 2) = (bf16_t)f2bf(acc[r] * mk[q][r]); } \
                } } \
            LDS_BARRIER(); \
            { \
                f32x4 acc = (f32x4){0.f, 0.f, 0.f, 0.f}; \
                _Pragma("unroll") for (int kk = 0; kk < 4; ++kk) { const bf16x8 af = *(const LAS bf16x8*)(B + O_QE + (16 * ti + fr) * SQ + (32 * kk + 8 * fq) * 2); \
                    const bf16x8 bf = *(const LAS bf16x8*)(lds + O_ST + (pb) * STSZ + (16 * vi + fr) * SQ + (32 * kk + 8 * fq) * 2); \
                    acc = __builtin_amdgcn_mfma_f32_16x16x32_bf16(af, bf, acc, 0, 0, 0); } \
                _Pragma("unroll") for (int r = 0; r < 4; ++r) acc[r] *= rsc[r]; \
                _Pragma("unroll") for (int kk = 0; kk < 2; ++kk) if (kk == 0 || ti >= 2) { const bf16x8 af = *(const LAS bf16x8*)(lds + O_P + (16 * ti + fr) * SK + (32 * kk + 8 * fq) * 2); \
                    const bf16x8 bf = *(const LAS bf16x8*)(B + SC_VT(16 * vi + fr, 4 * kk + fq)); \
                    acc = __builtin_amdgcn_mfma_f32_16x16x32_bf16(af, bf, acc, 0, 0, 0); } \
                _Pragma("unroll") for (int r = 0; r < 4; ++r) go[(n0 + 16 * ti + 4 * fq + r) * 256 + 16 * vi + fr] = (bf16_t)f2bf(acc[r]); \
            } \
            _Pragma("unroll") for (int q = 0; q < 2; ++q) { const int di = 2 * (wave >> 1) + q; \
                f32x4 acc = (f32x4){0.f, 0.f, 0.f, 0.f}; \
                _Pragma("unroll") for (int kk = 0; kk < 2; ++kk) { const bf16x8 af = *(const LAS bf16x8*)(B + SC_VT(16 * vi + fr, 4 * kk + fq)); \
                    const bf16x8 bf = *(const LAS bf16x8*)(B + SC_KT(16 * di + fr, 4 * kk + fq)); \
                    acc = __builtin_amdgcn_mfma_f32_16x16x32_bf16(af, bf, acc, 0, 0, 0); } \
                f32x4 Sn = (q == 0 ? S0 : S1) * sa[q] + acc * sb[q]; \
                if (q == 0) S0 = Sn; else S1 = Sn; \
                _Pragma("unroll") for (int r = 0; r < 4; ++r) *(LAS bf16_t*)(lds + O_ST + ((pb) ^ 1) * STSZ + (16 * vi + 4 * fq + r) * SQ + (16 * di + fr) * 2) = (bf16_t)f2bf(Sn[r] * se[q]); \
            } \
            if ((c) + 1 < 64) SC_WRITE(WQ, WK, WV, (pb) ^ 1); \
            _Pragma("unroll") for (int q = 0; q < 2; ++q) { sa[q] = na[q]; sb[q] = nb[q]; se[q] = ne[q]; } \
            LDS_BARRIER(); } while (0)
        float sa[2], sb[2], se[2], na[2], nb[2], ne[2];
        SC_SIDE(sa, sb, se, 0);
        SC_LOAD(rqA, rkA, rvA, 0);
        SC_WRITE(rqA, rkA, rvA, 0);
        SC_LOAD(rqA, rkA, rvA, 1);
        LDS_BARRIER();
        for (int c = 0; c < 64; c += 2) {
            SC_BODY(c, 0, rqB, rkB, rvB, rqA, rkA, rvA);
            SC_BODY(c + 1, 1, rqA, rkA, rvA, rqB, rkB, rvB);
        }
#undef SC_BODY
#undef SC_SIDE
#undef SC_KT
#undef SC_VT
#undef SC_LOAD
#undef SC_WRITE
    }
}

#define DPPF(x, ctrl, rmask) __builtin_bit_cast(float, __builtin_amdgcn_update_dpp(0, __builtin_bit_cast(int, x), ctrl, rmask, 0xF, true))
DEV float row16_sum_f(float x) { x += DPPF(x, 0xB1, 0xF); x += DPPF(x, 0x4E, 0xF); x += DPPF(x, 0x141, 0xF); x += DPPF(x, 0x140, 0xF); return x; }
DEV float wave_sum_dpp(float x) {
    x = row16_sum_f(x);
    x += __builtin_bit_cast(float, __builtin_amdgcn_update_dpp(0, __builtin_bit_cast(int, x), 0x142, 0xA, 0xF, false));
    x += __builtin_bit_cast(float, __builtin_amdgcn_update_dpp(0, __builtin_bit_cast(int, x), 0x143, 0xC, 0xF, false));
    return __builtin_bit_cast(float, __builtin_amdgcn_readlane(__builtin_bit_cast(int, x), 63));
}
typedef unsigned short u16x4 __attribute__((ext_vector_type(4)));
constexpr int CW_S = 144;
constexpr int CW_IMG = 64 * CW_S;
DEV unsigned lds_addr(const LAS unsigned char* p) { return (unsigned)(size_t)p; }
DEV bf16x8 cw_rowfrag(const LAS unsigned char* img, int rt, int kk, int fr, int fq) { return *(const LAS bf16x8*)(img + (16 * rt + fr) * CW_S + (32 * kk + 8 * fq) * 2); }
DEV void cw_trfrag2(const LAS unsigned char* img, int ct, int lane, bf16x8 (&f)[2]) {
    const int fq = lane >> 4, q = (lane & 15) >> 2, p = lane & 3;
    const unsigned a0 = lds_addr(img) + (8 * fq + q) * CW_S + (16 * ct + 4 * p) * 2;
    u16x4 r0, r1, r2, r3;
    asm volatile("ds_read_b64_tr_b16 %0, %4\n\tds_read_b64_tr_b16 %1, %4 offset:576\n\tds_read_b64_tr_b16 %2, %4 offset:4608\n\tds_read_b64_tr_b16 %3, %4 offset:5184\n\ts_waitcnt lgkmcnt(0)"
                 : "=&v"(r0), "=&v"(r1), "=&v"(r2), "=&v"(r3) : "v"(a0) : "memory");
    f[0] = (bf16x8){(short)r0[0], (short)r0[1], (short)r0[2], (short)r0[3], (short)r1[0], (short)r1[1], (short)r1[2], (short)r1[3]};
    f[1] = (bf16x8){(short)r2[0], (short)r2[1], (short)r2[2], (short)r2[3], (short)r3[0], (short)r3[1], (short)r3[2], (short)r3[3]};
}
template <bool ATR, bool BTR> DEV void cw_mm(const LAS unsigned char* Aimg, const LAS unsigned char* Bimg, int mt, int nt0, int lane, f32x4 (&acc)[2]) {
    const int fr = lane & 15, fq = lane >> 4;
    bf16x8 af[2], bf0[2], bf1[2];
    if (ATR) cw_trfrag2(Aimg, mt, lane, af); else { af[0] = cw_rowfrag(Aimg, mt, 0, fr, fq); af[1] = cw_rowfrag(Aimg, mt, 1, fr, fq); }
    if (BTR) { cw_trfrag2(Bimg, nt0, lane, bf0); cw_trfrag2(Bimg, nt0 + 1, lane, bf1); }
    else { bf0[0] = cw_rowfrag(Bimg, nt0, 0, fr, fq); bf0[1] = cw_rowfrag(Bimg, nt0, 1, fr, fq); bf1[0] = cw_rowfrag(Bimg, nt0 + 1, 0, fr, fq); bf1[1] = cw_rowfrag(Bimg, nt0 + 1, 1, fr, fq); }
    asm volatile("s_waitcnt lgkmcnt(0)" ::: "memory"); __builtin_amdgcn_sched_barrier(0);
#pragma unroll
    for (int kk = 0; kk < 2; ++kk) { acc[0] = __builtin_amdgcn_mfma_f32_16x16x32_bf16(af[kk], bf0[kk], acc[0], 0, 0, 0); acc[1] = __builtin_amdgcn_mfma_f32_16x16x32_bf16(af[kk], bf1[kk], acc[1], 0, 0, 0); }
}
DEV void cw_put(LAS unsigned char* img, int mt, int nt, int lane, const f32x4 v) {
    const int fr = lane & 15, fq = lane >> 4;
    u32x2 w; w.x = pk2(v[0], v[1]); w.y = pk2(v[2], v[3]);
    *(LAS u32x2*)(img + (16 * nt + fr) * CW_S + (16 * mt + 4 * fq) * 2) = w;
}
DEV void cw_trfrag4(const LAS unsigned char* imgA, int ctA, const LAS unsigned char* imgB, int ctB, int lane, bf16x8 (&fa)[2], bf16x8 (&fb)[2]) {
    const int fq = lane >> 4, q = (lane & 15) >> 2, p = lane & 3;
    const unsigned a0 = lds_addr(imgA) + (8 * fq + q) * CW_S + (16 * ctA + 4 * p) * 2, b0 = lds_addr(imgB) + (8 * fq + q) * CW_S + (16 * ctB + 4 * p) * 2;
    u16x4 r0, r1, r2, r3, r4, r5, r6, r7;
    asm volatile("ds_read_b64_tr_b16 %0, %8\n\tds_read_b64_tr_b16 %1, %8 offset:576\n\tds_read_b64_tr_b16 %2, %8 offset:4608\n\tds_read_b64_tr_b16 %3, %8 offset:5184\n\t"
                 "ds_read_b64_tr_b16 %4, %9\n\tds_read_b64_tr_b16 %5, %9 offset:576\n\tds_read_b64_tr_b16 %6, %9 offset:4608\n\tds_read_b64_tr_b16 %7, %9 offset:5184\n\ts_waitcnt lgkmcnt(0)"
                 : "=&v"(r0), "=&v"(r1), "=&v"(r2), "=&v"(r3), "=&v"(r4), "=&v"(r5), "=&v"(r6), "=&v"(r7) : "v"(a0), "v"(b0) : "memory");
    fa[0] = (bf16x8){(short)r0[0], (short)r0[1], (short)r0[2], (short)r0[3], (short)r1[0], (short)r1[1], (short)r1[2], (short)r1[3]};
    fa[1] = (bf16x8){(short)r2[0], (short)r2[1], (short)r2[2], (short)r2[3], (short)r3[0], (short)r3[1], (short)r3[2], (short)r3[3]};
    fb[0] = (bf16x8){(short)r4[0], (short)r4[1], (short)r4[2], (short)r4[3], (short)r5[0], (short)r5[1], (short)r5[2], (short)r5[3]};
    fb[1] = (bf16x8){(short)r6[0], (short)r6[1], (short)r6[2], (short)r6[3], (short)r7[0], (short)r7[1], (short)r7[2], (short)r7[3]};
}
#define CW_MMA(ACC, AF, B0, B1) do { _Pragma("unroll") for (int kk_ = 0; kk_ < 2; ++kk_) { \
        ACC[0] = __builtin_amdgcn_mfma_f32_16x16x32_bf16(AF[kk_], B0[kk_], ACC[0], 0, 0, 0); ACC[1] = __builtin_amdgcn_mfma_f32_16x16x32_bf16(AF[kk_], B1[kk_], ACC[1], 0, 0, 0); } } while (0)
#define CW_ZERO(X) X[0] = X[1] = (f32x4){0.f, 0.f, 0.f, 0.f}
#define CW_FENCE() do { asm volatile("s_waitcnt lgkmcnt(0)" ::: "memory"); __builtin_amdgcn_sched_barrier(0); } while (0)
constexpr size_t PO_CWPQ = 0;
constexpr size_t PO_CWRO = 8 * BLK_B;
typedef short bf16x4 __attribute__((ext_vector_type(4)));
DEV bf16x4 cvt4(const f32x4 v) { u32x2 w; w.x = pk2(v[0], v[1]); w.y = pk2(v[2], v[3]); return __builtin_bit_cast(bf16x4, w); }
DEV bf16x8 cat8(const bf16x4 a, const bf16x4 b) { return __builtin_shufflevector(a, b, 0, 1, 2, 3, 4, 5, 6, 7); }
DEV bf16x4 lo4(const bf16x8 v) { return __builtin_shufflevector(v, v, 0, 1, 2, 3); }
DEV bf16x4 hi4(const bf16x8 v) { return __builtin_shufflevector(v, v, 4, 5, 6, 7); }
DEV f32x4 up4(const bf16x4 v) { const u32x2 w = __builtin_bit_cast(u32x2, v); return (f32x4){bf2f(w.x & 0xffffu), __uint_as_float(w.x & 0xffff0000u), bf2f(w.y & 0xffffu), __uint_as_float(w.y & 0xffff0000u)}; }
#define MF16(A, B, C) __builtin_amdgcn_mfma_f32_16x16x16bf16_1k(A, B, C, 0, 0, 0)
#define MF32(A, B, C) __builtin_amdgcn_mfma_f32_16x16x32_bf16(A, B, C, 0, 0, 0)
constexpr int CW_AT = 0, CW_RT = 1, CW_BH = 2, CW_KH = 3;
constexpr int CWF = 4 * CW_IMG;
constexpr int CWF_AT = CWF, CWF_BH = CWF + 8192, CWF_KH = CWF + 16384, CWF_V = CWF + 24576;
constexpr int CWM = CWF + 4 * 8192;
constexpr int CWM_AB = CWM, CWM_AK = CWM + 8192, CWM_RB = CWM + 16384, CWM_RK = CWM + 24576;
constexpr int CWT = CWM + 4 * 8192;
constexpr int CW_SIDE = CWT + 2048;
static_assert(CW_SIDE + (8 * 64 + 3 * 64) * 4 <= LDS_MISC, "RW1 LDS map");
DEV void phase_rw1(KA& a, LAS unsigned char* lds, int l) {
    const int tid = opaque_tid(), lane = tid & 63, wave = tid >> 6, G = gridDim.x, wg = blockIdx.x;
    const int fr = lane & 15, fq = lane >> 4, mt = wave >> 1, nt0 = 2 * (wave & 1);
    float* RK = (float*)(a.ws + WS_RK);
    LAS float* side = (LAS float*)(lds + CW_SIDE);
#define IMG(i) (lds + (i) * CW_IMG)
    unsigned gr[8], gk[8], gv[8], glw[8], gla[8], gpr = 0, gpk = 0, gpv = 0;
    float pmur = 0.f, pmuk = 0.f, pmuv = 0.f, pw0 = 0.f, pa0 = 0.f, pkkp = 0.f, pkap = 0.f, prkp = 0.f;
#define RW1_LOAD(ci_) do { const int c_ = (ci_) & 63, h_ = ((ci_) >> 6) & 7, b_ = (ci_) >> 9, hb_ = h_ >> 2, cb_ = (h_ & 3) * 64 + (lane & ~1); \
        const size_t n_ = (size_t)b_ * T + c_ * 64 + wave * 8; \
        const unsigned* zr_ = (const unsigned*)(pool_blk(a, BK_RWR + hb_) + cb_); const unsigned* zk_ = (const unsigned*)(pool_blk(a, BK_RWK + hb_) + cb_); const unsigned* zv_ = (const unsigned*)(pool_blk(a, BK_RWV + hb_) + cb_); \
        const unsigned* lwp_ = (const unsigned*)(pool_blk(a, BK_LW + hb_) + cb_); const unsigned* lap_ = (const unsigned*)(pool_blk(a, BK_LA + hb_) + cb_); \
        _Pragma("unroll") for (int q = 0; q < 8; ++q) { gr[q] = zr_[(n_ + q) * 128]; gk[q] = zk_[(n_ + q) * 128]; gv[q] = zv_[(n_ + q) * 128]; glw[q] = lwp_[(n_ + q) * 128]; gla[q] = lap_[(n_ + q) * 128]; } \
        if ((n_ & (T - 1)) > 0) { gpr = zr_[(n_ - 1) * 128]; gpk = zk_[(n_ - 1) * 128]; gpv = zv_[(n_ - 1) * 128]; } else { gpr = 0; gpk = 0; gpv = 0; } \
        { const int ch_ = h_ * 64 + lane; pmur = FIN(I_MU)[l * 1792 + ch_]; pmuk = FIN(I_MU)[l * 1792 + 512 + ch_]; pmuv = FIN(I_MU)[l * 1792 + 1024 + ch_]; \
          pw0 = FIN(I_W0)[l * 512 + ch_]; pa0 = FIN(I_A0)[l * 512 + ch_]; pkkp = FIN(I_KK)[l * 512 + ch_]; pkap = FIN(I_KA)[l * 512 + ch_]; prkp = FIN(I_RK)[l * 512 + ch_]; } } while (0)
    const unsigned gsel = (lane & 1) ? 0x07060c0cu : 0x05040c0cu;
#define BFS(w) __uint_as_float(__builtin_amdgcn_perm((w), 0u, gsel))
    for (int i = tid; i < (4 * 8192 + 2048) / 4; i += 512) ((LAS unsigned*)(lds + CWM))[i] = 0u;
    if (wg < NB * 8 * 64) RW1_LOAD(wg);
    for (int ci = wg; ci < NB * 8 * 64; ci += G) {
        const int h = (ci >> 6) & 7, b = ci >> 9, c = ci & 63;
        const size_t n0 = (size_t)b * T + c * 64 + wave * 8;
        const float mur = pmur, muk = pmuk, muv = pmuv, w0 = pw0, a0 = pa0, kkp = pkkp, kap = pkap, rkp = prkp;
        float rs[8], ks[8], vs[8], lx[8], av[8], nk[8], sq[8], rkx[8];
        {
            float rp = BFS(gpr), kp_ = BFS(gpk), vp = BFS(gpv);
#pragma unroll
            for (int q = 0; q < 8; ++q) {
                const float r0 = BFS(gr[q]), k0 = BFS(gk[q]), v0 = BFS(gv[q]);
                rs[q] = r0 + mur * (rp - r0); ks[q] = k0 + muk * (kp_ - k0); vs[q] = v0 + muv * (vp - v0); rp = r0; kp_ = k0; vp = v0;
                lx[q] = -0.8750340975f * sigm(w0 + BFS(glw[q]));
                av[q] = sigm(a0 + BFS(gla[q]));
                nk[q] = ks[q] * kkp; sq[q] = nk[q] * nk[q];
                ks[q] = ks[q] * (1.f + (av[q] - 1.f) * kap);
                rkx[q] = rs[q] * ks[q] * rkp;
            }
        }
        __builtin_amdgcn_sched_barrier(0);
        { const int cn_ = (ci + G < NB * 8 * 64) ? ci + G : ci; RW1_LOAD(cn_); }
        {
            const bool b0 = (lane & 1) != 0, b1 = (lane & 2) != 0, b2 = (lane & 4) != 0, b3 = (lane & 8) != 0;
            float u[8], w4[4], z2[2];
#pragma unroll
            for (int i = 0; i < 8; ++i) { const float a_ = (i < 4) ? sq[2 * i] : rkx[2 * i - 8], b_ = (i < 4) ? sq[2 * i + 1] : rkx[2 * i - 7]; u[i] = (b0 ? b_ : a_) + DPPF(b0 ? a_ : b_, 0xB1, 0xF); }
#pragma unroll
            for (int i = 0; i < 4; ++i) w4[i] = (b1 ? u[2 * i + 1] : u[2 * i]) + DPPF(b1 ? u[2 * i] : u[2 * i + 1], 0x4E, 0xF);
#pragma unroll
            for (int i = 0; i < 2; ++i) z2[i] = (b2 ? w4[2 * i + 1] : w4[2 * i]) + DPPF(b2 ? w4[2 * i] : w4[2 * i + 1], 0x124, 0xF);
            float y = (b3 ? z2[1] : z2[0]) + DPPF(b3 ? z2[0] : z2[1], 0x128, 0xF);
            y += __builtin_bit_cast(float, __builtin_amdgcn_ds_bpermute((lane ^ 32) * 4, __builtin_bit_cast(int, y)));
            y += __builtin_bit_cast(float, __builtin_amdgcn_ds_bpermute((lane ^ 16) * 4, __builtin_bit_cast(int, y)));
#pragma unroll
            for (int q = 0; q < 8; ++q) { sq[q] = __builtin_bit_cast(float, __builtin_amdgcn_readlane(__builtin_bit_cast(int, y), q)); rkx[q] = __builtin_bit_cast(float, __builtin_amdgcn_readlane(__builtin_bit_cast(int, y), 8 + q)); }
        }
        float cl[8];
        { float run = 0.f;
#pragma unroll
          for (int q = 0; q < 8; ++q) { nk[q] = -nk[q] * __builtin_amdgcn_rsqf(fmaxf(sq[q], 1e-24f)); run += lx[q]; cl[q] = run; }
          if (lane == 0) {
#pragma unroll
              for (int q = 0; q < 8; ++q) RK[(n0 + q) * 8 + h] = rkx[q]; }
          side[wave * 64 + lane] = run; }
        LDS_BARRIER();
        float off = 0.f, ref = 0.f, tot = 0.f;
#pragma unroll
        for (int w2 = 0; w2 < 8; ++w2) { const float tv = side[w2 * 64 + lane]; if (w2 < wave) off += tv; if (w2 < 4) ref += tv; tot += tv; }
        const float eref = __builtin_amdgcn_exp2f(ref);
        if (wave == 0) { side[512 + lane] = eref; side[576 + lane] = __builtin_amdgcn_exp2f(tot); side[640 + lane] = __builtin_amdgcn_exp2f(tot - ref); }
        {
            float fa[8], fb[8], fk[8];
            float eprev = __builtin_amdgcn_exp2f(off - ref);
#pragma unroll
            for (int q = 0; q < 8; ++q) {
                const int t = wave * 8 + q; const float ci_ = off + cl[q];
                const float eu = __builtin_amdgcn_exp2f(ci_ - ref), ed = __builtin_amdgcn_exp2f(ref - ci_), ep = eprev; eprev = eu;
                const float at = nk[q] * ep, rt = rs[q] * eu; fb[q] = -nk[q] * av[q] * ed; fk[q] = ks[q] * ed; fa[q] = at * eref;
                *(LAS bf16_t*)(IMG(CW_AT) + t * CW_S + lane * 2) = (bf16_t)f2bf(at);
                *(LAS bf16_t*)(IMG(CW_RT) + t * CW_S + lane * 2) = (bf16_t)f2bf(rt);
                *(LAS bf16_t*)(IMG(CW_BH) + t * CW_S + lane * 2) = (bf16_t)f2bf(fb[q]);
                *(LAS bf16_t*)(IMG(CW_KH) + t * CW_S + lane * 2) = (bf16_t)f2bf(fk[q]);
            }
#pragma unroll
            for (int qh = 0; qh < 2; ++qh) {
                const int so = (((lane >> 4) * 2 + (wave >> 2)) * 64 + (2 * (wave & 1) + qh) * 16 + (lane & 15)) * 16 + ((wave >> 1) & 1) * 8;
                u32x2 w;
                w.x = pk2(fa[4 * qh], fa[4 * qh + 1]); w.y = pk2(fa[4 * qh + 2], fa[4 * qh + 3]); *(LAS u32x2*)(lds + CWF_AT + so) = w;
                w.x = pk2(fb[4 * qh], fb[4 * qh + 1]); w.y = pk2(fb[4 * qh + 2], fb[4 * qh + 3]); *(LAS u32x2*)(lds + CWF_BH + so) = w;
                w.x = pk2(fk[4 * qh], fk[4 * qh + 1]); w.y = pk2(fk[4 * qh + 2], fk[4 * qh + 3]); *(LAS u32x2*)(lds + CWF_KH + so) = w;
                w.x = pk2(vs[4 * qh], vs[4 * qh + 1]); w.y = pk2(vs[4 * qh + 2], vs[4 * qh + 3]); *(LAS u32x2*)(lds + CWF_V + so) = w;
            }
        }
        LDS_BARRIER();
#define LD2(F, img, blk) do { F[0] = cw_rowfrag(IMG(img), (blk), 0, fr, fq); F[1] = cw_rowfrag(IMG(img), (blk), 1, fr, fq); } while (0)
#define MM2(XA, YB) MF32(XA[1], YB[1], MF32(XA[0], YB[0], Z0))
#define PUTM(base, i, j, C) (*(LAS bf16x4*)(lds + (base) + (((i) * 2 + ((j) >> 1)) * 64 + lane) * 16 + ((j) & 1) * 8) = cvt4(C))
        const f32x4 Z0 = {0.f, 0.f, 0.f, 0.f};
        if (wave < 4) {
            const int i = wave;
            bf16x8 ya[2], xb[2]; LD2(ya, CW_AT, i); LD2(xb, CW_BH, i);
            f32x4 X = MM2(ya, xb), Xt = MM2(xb, ya), St;
#pragma unroll
            for (int r = 0; r < 4; ++r) { X[r] = (4 * fq + r > fr) ? X[r] : 0.f; Xt[r] = (fr > 4 * fq + r) ? Xt[r] : 0.f; St[r] = Xt[r] + ((4 * fq + r == fr) ? 1.f : 0.f); }
            const bf16x4 c0 = cvt4(X), c0t = cvt4(Xt);
            const f32x4 P1 = MF16(c0t, c0, Z0), P1t = MF16(c0, c0t, Z0);
            const bf16x4 c1 = cvt4(P1), c1t = cvt4(P1t);
            St = MF16(c1, cvt4(St), St);
            const f32x4 P2 = MF16(c1t, c1, Z0), P2t = MF16(c1, c1t, Z0);
            const bf16x4 c2 = cvt4(P2), c2t = cvt4(P2t);
            St = MF16(c2, cvt4(St), St);
            const f32x4 P3 = MF16(c2t, c2, Z0);
            St = MF16(cvt4(P3), cvt4(St), St);
            *(LAS bf16x4*)(lds + CWT + (i * 64 + lane) * 8) = cvt4(St);
        } else {
            const int u = wave - 4;
            {
                bf16x8 xb[2], xk[2], ya[2], yr[2]; LD2(xb, CW_BH, u); LD2(xk, CW_KH, u); LD2(ya, CW_AT, u); LD2(yr, CW_RT, u);
                f32x4 ak = MM2(xk, ya), rb = MM2(xb, yr), rk = MM2(xk, yr);
#pragma unroll
                for (int r = 0; r < 4; ++r) { ak[r] = (fr > 4 * fq + r) ? ak[r] : 0.f; rb[r] = (fr >= 4 * fq + r) ? rb[r] : 0.f; rk[r] = (fr >= 4 * fq + r) ? rk[r] : 0.f; }
                PUTM(CWM_AK, u, u, ak); PUTM(CWM_RB, u, u, rb); PUTM(CWM_RK, u, u, rk);
            }
            {
                const int i = (u == 0) ? 1 : (u == 3 ? 3 : 2), j = u >> 1;
                bf16x8 xb[2], xk[2], ya[2], yr[2]; LD2(xb, CW_BH, j); LD2(xk, CW_KH, j); LD2(ya, CW_AT, i); LD2(yr, CW_RT, i);
                PUTM(CWM_AB, i, j, MM2(xb, ya)); PUTM(CWM_AK, i, j, MM2(xk, ya)); PUTM(CWM_RB, i, j, MM2(xb, yr)); PUTM(CWM_RK, i, j, MM2(xk, yr));
            }
            {
                const int j = (u < 2) ? 0 : 2;
                bf16x8 xb[2], xk[2], y[2]; LD2(xb, CW_BH, j); LD2(xk, CW_KH, j);
                if (u & 1) { LD2(y, CW_RT, 3); PUTM(CWM_RB, 3, j, MM2(xb, y)); PUTM(CWM_RK, 3, j, MM2(xk, y)); }
                else       { LD2(y, CW_AT, 3); PUTM(CWM_AB, 3, j, MM2(xb, y)); PUTM(CWM_AK, 3, j, MM2(xk, y)); }
            }
        }
        LDS_BARRIER();
        {
            const int kind = wave >> 2, st = wave & 3;
            unsigned char* gpq = a.ws + WS_POOL + PO_CWPQ + (size_t)ci * 16384; unsigned char* gro = a.ws + WS_POOL + PO_CWRO + (size_t)ci * 16384;
#define FM64(base, i, j) (*(const LAS bf16x4*)(lds + (base) + (((i) * 2 + ((j) >> 1)) * 64 + lane) * 16 + ((j) & 1) * 8))
#define FM128(base, i, jp) (*(const LAS bf16x8*)(lds + (base) + (((i) * 2 + (jp)) * 64 + lane) * 16))
#define MFP(A8, B8, C) MF32(A8, B8, C)
#define LTRI(OUT, base, ACC, B01, B23) do { \
                OUT[0] = MFP(FM128(base, 0, 0), B01, ACC[0]); OUT[1] = MFP(FM128(base, 1, 0), B01, ACC[1]); \
                OUT[2] = MFP(FM128(base, 2, 1), B23, MFP(FM128(base, 2, 0), B01, ACC[2])); OUT[3] = MFP(FM128(base, 3, 1), B23, MFP(FM128(base, 3, 0), B01, ACC[3])); } while (0)
#define LTRIT(OUT, base, ACC, A01, A23) do { \
                OUT[0] = MFP(A01, FM128(base, 0, 0), ACC[0]); OUT[1] = MFP(A01, FM128(base, 1, 0), ACC[1]); \
                OUT[2] = MFP(A23, FM128(base, 2, 1), MFP(A01, FM128(base, 2, 0), ACC[2])); OUT[3] = MFP(A23, FM128(base, 3, 1), MFP(A01, FM128(base, 3, 0), ACC[3])); } while (0)
            bf16x4 ft[4];
#pragma unroll
            for (int i = 0; i < 4; ++i) ft[i] = *(const LAS bf16x4*)(lds + CWT + (i * 64 + lane) * 8);
            const bf16x4 ab10 = FM64(CWM_AB, 1, 0); const bf16x8 ab2 = FM128(CWM_AB, 2, 0), ab3 = FM128(CWM_AB, 3, 0), ab3h = FM128(CWM_AB, 3, 1);
            f32x4 R[4]; bf16x8 vf[2] = {};
            if (kind == 0) { const bf16x8 r01 = FM128(CWF_AT, st, 0), r23 = FM128(CWF_AT, st, 1); R[0] = up4(lo4(r01)); R[1] = up4(hi4(r01)); R[2] = up4(lo4(r23)); R[3] = up4(hi4(r23)); }
            else { vf[0] = FM128(CWF_V, st, 0); vf[1] = FM128(CWF_V, st, 1); const f32x4 zz[4] = {Z0, Z0, Z0, Z0}; LTRI(R, CWM_AK, zz, vf[0], vf[1]); }
            bf16x4 c[4];
            c[0] = cvt4(MF16(ft[0], cvt4(R[0]), Z0));
            c[1] = cvt4(MF16(ft[1], cvt4(MF16(ab10, c[0], R[1])), Z0));
            const bf16x8 c01 = cat8(c[0], c[1]);
            c[2] = cvt4(MF16(ft[2], cvt4(MFP(ab2, c01, R[2])), Z0));
            c[3] = cvt4(MF16(ft[3], cvt4(MFP(ab3h, cat8(c[2], c[2]), MFP(ab3, c01, R[3]))), Z0));
            const bf16x8 c23 = cat8(c[2], c[3]);
            const int col = 16 * st + fr;
            if (kind == 0) {
                const f32x4 er4 = *(const LAS f32x4*)(side + 512 + 16 * st + 4 * fq);
                f32x4 xr[4];
#pragma unroll
                for (int i = 0; i < 4; ++i) xr[i] = up4(*(const LAS bf16x4*)(IMG(CW_RT) + (16 * i + fr) * CW_S + (16 * st + 4 * fq) * 2)) * er4;
                LTRIT(xr, CWM_RB, xr, c01, c23);
#pragma unroll
                for (int i = 0; i < 4; ++i) {
                    const f32x4 xp = MFP(c23, FM128(CWF_BH, i, 1), MFP(c01, FM128(CWF_BH, i, 0), Z0));
                    const float etr = side[640 + 16 * i + fr], etot = side[576 + 16 * i + fr];
                    f32x4 pv;
#pragma unroll
                    for (int r = 0; r < 4; ++r) pv[r] = xp[r] * etr + ((i == st && 4 * fq + r == fr) ? etot : 0.f);
                    *(bf16x4*)(gro + ((i * 2 + (st >> 1)) * 64 + lane) * 16 + (st & 1) * 8) = cvt4(xr[i]);
                    *(bf16x4*)(gpq + ((i * 2 + (st >> 1)) * 64 + lane) * 16 + (st & 1) * 8) = cvt4(pv);
                }
            } else {
                f32x4 xo[4]; { const f32x4 zz[4] = {Z0, Z0, Z0, Z0}; LTRI(xo, CWM_RB, zz, c01, c23); }
                LTRI(xo, CWM_RK, xo, vf[0], vf[1]);
#pragma unroll
                for (int i = 0; i < 4; ++i) {
                    f32x4 xq = MFP(FM128(CWF_BH, i, 1), c23, MFP(FM128(CWF_BH, i, 0), c01, Z0));
                    xq = MFP(FM128(CWF_KH, i, 1), vf[1], MFP(FM128(CWF_KH, i, 0), vf[0], xq));
                    u32x2 w; w.x = pk2(xo[i][0], xo[i][1]); w.y = pk2(xo[i][2], xo[i][3]); *(u32x2*)(gro + 8192 + ((i * 4 + st) * 64 + lane) * 8) = w;
                    const f32x4 et4 = *(const LAS f32x4*)(side + 640 + 16 * i + 4 * fq);
                    w.x = pk2(xq[0] * et4[0], xq[1] * et4[1]); w.y = pk2(xq[2] * et4[2], xq[3] * et4[3]);
                    *(u32x2*)(gpq + 8192 + ((i * 4 + st) * 64 + lane) * 8) = w;
                }
            }
#undef FM64
#undef FM128
#undef MFP
#undef LTRI
#undef LTRIT
        }
#undef LD2
#undef MM2
#undef PUTM
    }
#undef IMG
#undef RW1_LOAD
#undef BFS
}
template <int PART> DEV void mpost_tokens(KA& a, int l, int n_lo, int n_hi, int w0, int wstride, const bool dum);
constexpr int RW2_POST_TOK = 10880;
DEV void phase_rw2(KA& a, LAS unsigned char* lds, int l, const bool dum = false) {
    const int tid = opaque_tid(), lane = tid & 63, wave = __builtin_amdgcn_readfirstlane(tid >> 6), G = gridDim.x, wg = blockIdx.x;
    const int fr = lane & 15, fq = lane >> 4, mt = wave >> 1, nt0 = 2 * (wave & 1);
    constexpr int RING = 16384, SLOT = 32768;
    static_assert(RING + 4 * SLOT <= LDS_MISC, "RW2 LDS map");
    for (int item = wg; item < 256; item += G) {
        const int qd = 3 - (item >> 6), bh = item & 63, h = bh & 7, b = bh >> 3, hb = h >> 2, cb = (h & 3) * 64;
        const int nsteps = 16 * qd + 16, c_out = 16 * qd;
        bf16_t* op = pool_blk(a, (dum ? 30 : BK_RWO) + hb) + cb;
        const unsigned char* gpq = a.ws + WS_POOL + PO_CWPQ + (size_t)bh * 64 * 16384 + tid * 16; const unsigned char* gro = a.ws + WS_POOL + PO_CWRO + (size_t)bh * 64 * 16384 + tid * 16;
        __syncthreads();
        for (int i = tid; i < 2 * 8192 / 4; i += 512) ((LAS unsigned*)lds)[i] = 0u;
#define RW2_ISSUE(s) do { const int s_ = (s); const int r_ = s_ < nsteps ? s_ : nsteps - 1; LAS unsigned char* d_ = lds + RING + (s_ & 3) * SLOT + wave * 1024; \
            const unsigned char* p_ = gpq + (size_t)r_ * 16384; \
            __builtin_amdgcn_global_load_lds((const unsigned*)p_, (LAS unsigned*)d_, 16, 0, 0); __builtin_amdgcn_global_load_lds((const unsigned*)(p_ + 8192), (LAS unsigned*)(d_ + 8192), 16, 0, 0); \
            if (s_ >= c_out) { const unsigned char* q_ = gro + (size_t)r_ * 16384; \
                __builtin_amdgcn_global_load_lds((const unsigned*)q_, (LAS unsigned*)(d_ + 16384), 16, 0, 0); __builtin_amdgcn_global_load_lds((const unsigned*)(q_ + 8192), (LAS unsigned*)(d_ + 24576), 16, 0, 0); } } while (0)
        RW2_ISSUE(0); RW2_ISSUE(1); RW2_ISSUE(2);
        asm volatile("s_waitcnt vmcnt(4)" ::: "memory");
        LDS_BARRIER();
        for (int c = 0; c < nsteps; ++c) {
            RW2_ISSUE(c + 3);
            const LAS unsigned char* Hc = lds + (c & 1) * 8192; LAS unsigned char* Hn = lds + ((c + 1) & 1) * 8192;
            const LAS unsigned char* sl = lds + RING + (c & 3) * SLOT;
            bf16x8 hb0[2], hb1[2];
            hb0[0] = *(const LAS bf16x8*)(Hc + ((nt0 * 2) * 64 + lane) * 16); hb0[1] = *(const LAS bf16x8*)(Hc + ((nt0 * 2 + 1) * 64 + lane) * 16);
            hb1[0] = *(const LAS bf16x8*)(Hc + ((nt0 * 2 + 2) * 64 + lane) * 16); hb1[1] = *(const LAS bf16x8*)(Hc + ((nt0 * 2 + 3) * 64 + lane) * 16);
            const bf16x8 paf0 = *(const LAS bf16x8*)(sl + ((mt * 2) * 64 + lane) * 16), paf1 = *(const LAS bf16x8*)(sl + ((mt * 2 + 1) * 64 + lane) * 16);
            f32x4 hn[2];
            hn[0] = up4(*(const LAS bf16x4*)(sl + 8192 + ((mt * 4 + nt0) * 64 + lane) * 8)); hn[1] = up4(*(const LAS bf16x4*)(sl + 8192 + ((mt * 4 + nt0 + 1) * 64 + lane) * 8));
            hn[0] = __builtin_amdgcn_mfma_f32_16x16x32_bf16(paf0, hb0[0], hn[0], 0, 0, 0); hn[0] = __builtin_amdgcn_mfma_f32_16x16x32_bf16(paf1, hb0[1], hn[0], 0, 0, 0);
            hn[1] = __builtin_amdgcn_mfma_f32_16x16x32_bf16(paf0, hb1[0], hn[1], 0, 0, 0); hn[1] = __builtin_amdgcn_mfma_f32_16x16x32_bf16(paf1, hb1[1], hn[1], 0, 0, 0);
            *(LAS bf16x4*)(Hn + ((nt0 * 2 + (mt >> 1)) * 64 + lane) * 16 + (mt & 1) * 8) = cvt4(hn[0]); *(LAS bf16x4*)(Hn + ((nt0 * 2 + 2 + (mt >> 1)) * 64 + lane) * 16 + (mt & 1) * 8) = cvt4(hn[1]);
            if (c >= c_out) {
                const bf16x8 raf0 = *(const LAS bf16x8*)(sl + 16384 + ((mt * 2) * 64 + lane) * 16), raf1 = *(const LAS bf16x8*)(sl + 16384 + ((mt * 2 + 1) * 64 + lane) * 16);
                f32x4 o[2];
                o[0] = up4(*(const LAS bf16x4*)(sl + 24576 + ((mt * 4 + nt0) * 64 + lane) * 8)); o[1] = up4(*(const LAS bf16x4*)(sl + 24576 + ((mt * 4 + nt0 + 1) * 64 + lane) * 8));
                o[0] = __builtin_amdgcn_mfma_f32_16x16x32_bf16(raf0, hb0[0], o[0], 0, 0, 0); o[0] = __builtin_amdgcn_mfma_f32_16x16x32_bf16(raf1, hb0[1], o[0], 0, 0, 0);
                o[1] = __builtin_amdgcn_mfma_f32_16x16x32_bf16(raf0, hb1[0], o[1], 0, 0, 0); o[1] = __builtin_amdgcn_mfma_f32_16x16x32_bf16(raf1, hb1[1], o[1], 0, 0, 0);
                const size_t nb_ = (size_t)b * T + (size_t)c * 64;
#pragma unroll
                for (int j = 0; j < 2; ++j)
#pragma unroll
                    for (int r = 0; r < 4; ++r) op[(nb_ + 16 * mt + 4 * fq + r) * 256 + 16 * (nt0 + j) + fr] = (bf16_t)f2bf(o[j][r]);
            }
            if (c - 2 >= c_out) asm volatile("s_waitcnt vmcnt(32)" ::: "memory"); else asm volatile("s_waitcnt vmcnt(4)" ::: "memory");
            LDS_BARRIER();
        }
#undef RW2_ISSUE
        asm volatile("s_waitcnt vmcnt(0)" ::: "memory");
        LDS_BARRIER();
        { const int nu = 3 - qd, u0 = bh * 6 + (qd == 0 ? 0 : (qd == 1 ? 3 : 5));
          if (nu > 0) mpost_tokens<0>(a, l, (u0 * RW2_POST_TOK) / 384, ((u0 + nu) * RW2_POST_TOK) / 384, wave, 8, dum); }
    }
}

template <int PART> DEV void mpost_tokens(KA& a, int l, int n_lo, int n_hi, int w0, int wstride, const bool dum) {
    const int lane = opaque_tid() & 63;
    const int c0 = 8 * lane, blk = c0 >> 8, col = c0 & 255;
    const float* RK = (const float*)(a.ws + WS_RK);
    float nw[8], lnw[8], lnb[8], muv[8];
#pragma unroll
    for (int j = 0; j < 8; ++j) { nw[j] = FIN(I_HGNW)[l * 128 + (c0 & 127) + j]; lnw[j] = FIN(I_LNW)[l * 512 + c0 + j]; lnb[j] = FIN(I_LNB)[l * 512 + c0 + j]; muv[j] = FIN(I_MU)[l * 1792 + 1024 + c0 + j]; }
#pragma unroll 2
    for (int n = n_lo + w0; n < n_hi; n += wstride) {
        const size_t off = (size_t)n * 256 + col;
        float o[8], g[8], r_[8];
        if (PART == 0) {
        {
            u32x4* op = (u32x4*)(pool_blk(a, BK_HGI + blk) + off);
            unpack8(*op, o); unpack8(*(const u32x4*)(pool_blk(a, BK_HGG + blk) + off), g);
            float ss = 0.f;
#pragma unroll
            for (int j = 0; j < 8; ++j) ss += o[j] * o[j];
            ss = row16_sum(ss);
            const float r = __builtin_amdgcn_rsqf(ss * (1.f / 128.f) + NORM_EPS);
#pragma unroll
            for (int j = 0; j < 8; ++j) r_[j] = o[j] * r * nw[j] * silu(g[j]);
            *(dum ? (u32x4*)(pool_blk(a, 16 + blk) + off) : op) = pack8(r_);
        }
        {
            u32x4* op = (u32x4*)(pool_blk(a, BK_RTV + blk) + off);
            unpack8(*op, o); unpack8(*(const u32x4*)(pool_blk(a, BK_RTG + blk) + off), g);
            float ss = 0.f;
#pragma unroll
            for (int j = 0; j < 8; ++j) ss += o[j] * o[j];
            ss = row16_sum(ss);
            const float r = __builtin_amdgcn_rsqf(ss * (1.f / 128.f) + NORM_EPS);
#pragma unroll
            for (int j = 0; j < 8; ++j) r_[j] = o[j] * r * silu(g[j]);
            *(dum ? (u32x4*)(pool_blk(a, 18 + blk) + off) : op) = pack8(r_);
        }
        } else {
            float v0[8], vp[8];
            unpack8(*(const u32x4*)(pool_blk(a, BK_RWO + blk) + off), o);
            u32x4* gp = (u32x4*)(pool_blk(a, BK_LG + blk) + off);
            unpack8(*gp, g);
            unpack8(*(const u32x4*)(pool_blk(a, BK_RWV + blk) + off), v0);
            if ((n & (T - 1)) > 0) unpack8(*(const u32x4*)(pool_blk(a, BK_RWV + blk) + off - 256), vp);
            else {
#pragma unroll
                for (int j = 0; j < 8; ++j) vp[j] = 0.f; }
            float s = 0.f;
#pragma unroll
            for (int j = 0; j < 8; ++j) s += o[j];
            const float mean = row8_sum(s) * (1.f / 64.f);
            float q = 0.f;
#pragma unroll
            for (int j = 0; j < 8; ++j) { const float dd = o[j] - mean; q += dd * dd; }
            const float var = row8_sum(q) * (1.f / 64.f);
            const float rs = __builtin_amdgcn_rsqf(var + RW_GN_EPS);
            const float rk = RK[(size_t)n * 8 + (lane >> 3)];
#pragma unroll
            for (int j = 0; j < 8; ++j) { const float vs = v0[j] + muv[j] * (vp[j] - v0[j]); r_[j] = ((o[j] - mean) * rs * lnw[j] + lnb[j] + rk * vs) * g[j]; }
            *(dum ? (u32x4*)(pool_blk(a, 8 + blk) + off) : gp) = pack8(r_);
        }
    }
}
DEV void phase_mpost(KA& a, int l, const bool dum = false) {
    const int wave = opaque_tid() >> 6;
    mpost_tokens<1>(a, l, 0, NTOK, blockIdx.x * 8 + wave, gridDim.x * 8, dum);
    mpost_tokens<0>(a, l, RW2_POST_TOK, NTOK, blockIdx.x * 8 + wave, gridDim.x * 8, dum);
}

DEV void phase_gather(KA& a, LAS unsigned char* lds) {
    const int tid = opaque_tid(), lane = tid & 63, wave = tid >> 6, G = gridDim.x, wg = blockIdx.x;
    LAS int* tot = (LAS int*)lds; LAS int* base = tot + 32; LAS int* se = tot + 64; LAS int* part = tot + 64 + 256;
    const int* cnt = (const int*)(a.ws + WS_CNT); const int* sele = (const int*)(a.ws + WS_SEL_E); int* selp = (int*)(a.ws + WS_SEL_P);
    int* tilemap = (int*)(a.ws + WS_TILEMAP); int* rowtok = (int*)(a.ws + WS_ROWTOK);
    for (int grp = wg; grp < NTOK / 128; grp += G) {
        __syncthreads();
        {
            const int e = tid & 31, pt = tid >> 5; int t_ = 0, bf = 0;
#pragma unroll
            for (int i = 0; i < 16; ++i) { const int g = pt * 16 + i; const int cval = cnt[g * 32 + e]; t_ += cval; bf += (g < grp) ? cval : 0; }
            part[pt * 32 + e] = t_; part[512 + pt * 32 + e] = bf; }
        if (tid < 256) se[tid] = sele[grp * 256 + tid];
        __syncthreads();
        if (tid < 64) {
            const int e = lane & 31; int t_ = 0, bf = 0;
#pragma unroll
            for (int i = 0; i < 16; ++i) { t_ += part[i * 32 + e]; bf += part[512 + i * 32 + e]; }
            const int mt = (t_ + 255) >> 8; int incl = mt;
#pragma unroll
            for (int d = 1; d < 32; d <<= 1) { const int v = __builtin_amdgcn_ds_bpermute(((lane - d) & 63) * 4, incl); if (e >= d) incl += v; }
            const int excl = incl - mt;
            if (lane < 32) { tot[e] = t_; base[e] = bf + excl * 256;
                if (grp == 0) { for (int k = 0; k < mt; ++k) tilemap[1 + excl + k] = e; if (e == 31) tilemap[0] = incl; } } }
        __syncthreads();
#pragma unroll
        for (int q = 0; q < 4; ++q) { const int e = wave * 4 + q; int run = base[e];
#pragma unroll
            for (int k = 0; k < 4; ++k) { const int i = 64 * k + lane; const bool hit = se[i] == e; const unsigned long long m = __ballot(hit);
                if (hit) { const int p = run + (int)__builtin_amdgcn_mbcnt_hi((unsigned)(m >> 32), __builtin_amdgcn_mbcnt_lo((unsigned)m, 0u)); selp[grp * 256 + i] = p; rowtok[p] = grp * 128 + (i >> 1); }
                run += __popcll(m); } }
        if (grp == 0) {
            for (int e = 0; e < 32; ++e) { const int cnt_e = tot[e], end_e = ((cnt_e + 255) >> 8) << 8; for (int p = cnt_e + tid; p < end_e; p += 512) rowtok[base[e] + p] = 0; } }
        __syncthreads();
    }
}

constexpr int PH_PER_LAYER = 17, PH_FINAL = 1 + 2 * PH_PER_LAYER, PH_COUNT = PH_FINAL + 1;
#ifndef MK_PHMASK
#define MK_PHMASK 0x7ffffull
#endif
#define IN(k) (lo <= (k) && (k) < hi)
#define PH(k, idx) (IN(k) && ((MK_PHMASK >> (idx)) & 1ull))
#ifndef MK_REP_IDX
#define MK_REP_IDX -1
#endif
#ifndef MK_REP_L
#define MK_REP_L -1
#endif
#define REP(idx) for (int rep_ = 0; rep_ < ((MK_REP_IDX == (idx) && (MK_REP_L < 0 || MK_REP_L == l)) ? 2 : 1); ++rep_)
#define SEAM(k) do { if (IN(k) && IN((k) + 1)) xcd_barrier(bar); } while (0)
#define KARGS() (*({ KA* ap_ = (KA*)__builtin_amdgcn_kernarg_segment_ptr(); asm volatile("" : "+s"(ap_)); ap_; }))
#define POOL ((bf16_t*)(a.ws + WS_POOL))
#define HBUF ((bf16_t*)(a.ws + WS_H))
template <int L> DEV void run_layer(LAS unsigned char* lds, const int lo, const int hi, const XcdBarrier& bar) {
    constexpr int l = L;
    const int G = gridDim.x, wg = blockIdx.x;
        const int pb = 1 + PH_PER_LAYER * l;
#define WINT ((const bf16_t*)(a.ws + WS_WIN) + (size_t)l * INC * 1024)
        if (PH(pb + 0, 0)) REP(0) { KA& a = KARGS(); if (l == 0) phase_norm<0>(a, lds, 0); else phase_norm<1>(a, lds, l); }
        SEAM(pb + 0);
        if (PH(pb + 1, 1)) REP(1) { KA& a = KARGS(); pg8::Gemm g{HBUF, WINT, 1024, 1024, 512, 0, 0}; pg8::DenseOrder S; S.init(NTOK, ZMIXC, G, wg, 0); pg8::EpiBlk<0, 0> E{POOL};
            pg8::gemm_phase(lds, g, S, E); }
        SEAM(pb + 1);
        if (PH(pb + 2, 2)) REP(2) { KA& a = KARGS(); phase_mpre(a, lds, l, MK_REP_IDX == 2 && rep_ == 0); }
        SEAM(pb + 2);
        if (PH(pb + 3, 3)) REP(3) { KA& a = KARGS(); pg8::Gemm g{pool_blk(a, BK_LIN), (const bf16_t*)(a.ws + WS_LORAB) + (size_t)l * 1536 * 256, 256, 256, 512, 0, 0}; pg8::DenseOrder S; S.init(NTOK, 1536, G, wg, 0); pg8::EpiBlk<1, 0> E{POOL};
            pg8::gemm_phase(lds, g, S, E); }
        if (PH(pb + 4, 4)) REP(4) { KA& a = KARGS();
            phase_scan_chunk(a, lds, l, MK_REP_IDX == 4 && rep_ == 0);
        }
        SEAM(pb + 4);
        if (PH(pb + 5, 5)) REP(5) { KA& a = KARGS(); phase_rw1(a, lds, l); }
        SEAM(pb + 5);
        if (PH(pb + 6, 6)) REP(6) { KA& a = KARGS(); phase_rw2(a, lds, l, MK_REP_IDX == 6 && rep_ == 0); }
        SEAM(pb + 6);
        if (PH(pb + 7, 7)) REP(7) { KA& a = KARGS(); phase_mpost(a, l, MK_REP_IDX == 7 && rep_ == 0); }
        SEAM(pb + 7);
        if (PH(pb + 8, 8)) REP(8) { KA& a = KARGS(); pg8::Gemm g{HBUF, WINT, 1024, 1024, 512, 0, 0}; pg8::DenseOrder S; S.init(NTOK, GATEC, G, wg, ZMIXC / 256); pg8::EpiBlk<2, 1> E{POOL};
            pg8::gemm_phase(lds, g, S, E); }
        SEAM(pb + 8);
        {
#define YF32 ((float*)pool_blk(a, BK_YF))
#define YBF ((bf16_t*)pool_blk(a, BK_YB))
#define BRT ((const bf16_t*)(a.ws + WS_BR) + (size_t)l * 1024 * 1536)
            if (PH(pb + 9, 9)) REP(9) { KA& a = KARGS(); pg8::Gemm g{pool_blk(a, BK_HGI), BRT, 1536, 256, BLK_B, (size_t)(BK_RTV - BK_HGI) * BLK_B, (size_t)(BK_LG - BK_HGI) * BLK_B}; pg8::DenseOrder S; S.init(NTOK, 1024, G, wg, 0);
                pg8::EpiHorner E{POOL, YBF};
                pg8::gemm_phase<true>(lds, g, S, E); }
            SEAM(pb + 11);
        }
        if (PH(pb + 12, 12)) REP(12) { KA& a = KARGS(); pg8::Gemm g{pool_blk(a, BK_YB), (const bf16_t*)(a.ws + WS_WOUT) + (size_t)l * 1024 * 1024, 1024, 256, BLK_B, 0, 0}; pg8::DenseOrder S; S.init(NTOK, 1024, G, wg, 0);
            if (l == 0) { pg8::EpiResid<true> E{FIN(I_X), (bf16_t*)a.out, (const float*)(a.ws + WS_MOD) + (size_t)l * 8 * 6144 + 2048}; pg8::gemm_phase(lds, g, S, E); }
            else { pg8::EpiResid<false> E{nullptr, (bf16_t*)a.out, (const float*)(a.ws + WS_MOD) + (size_t)l * 8 * 6144 + 2048}; pg8::gemm_phase(lds, g, S, E); } }
        SEAM(pb + 12);
        if (PH(pb + 13, 13)) REP(13) { KA& a = KARGS(); phase_norm<2>(a, lds, l); }
        SEAM(pb + 13);
        if (PH(pb + 14, 14)) REP(14) { KA& a = KARGS(); phase_gather(a, lds); }
        SEAM(pb + 14);
        if (PH(pb + 15, 15)) REP(15) { KA& a = KARGS(); pg8::Gemm g{HBUF, (const bf16_t*)(a.ws + WS_POOL + PO_W13), 1024, 1024, 512, 0, 0}; pg8::MoeOrder S; S.init((const int*)(a.ws + WS_TILEMAP), G, (G % 8 == 0) ? (wg % 8) * (G / 8) + wg / 8 : wg, (const int*)(a.ws + WS_ROWTOK));
            pg8::EpiSwiglu E{(bf16_t*)(a.ws + WS_POOL + PO_ACT)};
            pg8::gemm_phase<false, true>(lds, g, S, E); }
        SEAM(pb + 15);
        if (PH(pb + 16, 16)) REP(16) { KA& a = KARGS(); pg8::Gemm g{(const bf16_t*)(a.ws + WS_POOL + PO_ACT), (const bf16_t*)(a.ws + WS_POOL + PO_W2), 512, 512, 512, 0, 0}; pg8::MoeOrder S; S.init((const int*)(a.ws + WS_TILEMAP), G, (G % 8 == 0) ? (wg % 8) * (G / 8) + wg / 8 : wg);
            pg8::EpiRowBf16 E{(bf16_t*)(a.ws + WS_POOL + PO_Y2), 1024};
            pg8::gemm_phase(lds, g, S, E); }
        SEAM(pb + 16);
    }
__global__ void __launch_bounds__(512, 2) mk_fwd(Args a_unused) {
    extern __shared__ __attribute__((aligned(16))) unsigned char lds_raw[];
    LAS unsigned char* lds = (LAS unsigned char*)lds_raw;
    volatile LAS unsigned* misc = (volatile LAS unsigned*)(lds + LDS_MISC);
    if (threadIdx.x < 16) misc[threadIdx.x] = 0u;
    __syncthreads();
    int lo, hi; XcdBarrier bar;
    { KA& a = KARGS(); lo = a.ph_lo; hi = a.ph_hi; bar.bar = (unsigned*)(a.ws + WS_CTL); bar.x = 0; bar.st = misc;
      if (hi - lo > 1) bar = xcd_barrier_post((unsigned*)(a.ws + WS_CTL), misc); }

    constexpr int l = 0;
    if (PH(0, 17)) REP(17) { KA& a = KARGS(); phase_prologue(a, lds); }
    SEAM(0);
    run_layer<0>(lds, lo, hi, bar);
    run_layer<1>(lds, lo, hi, bar);
    if (PH(PH_FINAL, 18)) REP(18) { KA& a = KARGS(); phase_norm<3>(a, lds, 0); }
#undef IN
#undef PH
#undef SEAM
}

extern "C" void kernel_launch(void* const* d_in, const int* in_sizes, int n_in, void* d_out, int out_size, void* d_ws, size_t ws_size, hipStream_t stream) {
    static int grid = 0;
    if (grid == 0) {
        if (n_in != 31 || in_sizes[0] != NTOK * D || out_size != NTOK * D || ws_size < WS_END) {
            fprintf(stderr, "kernel_launch: unexpected shapes (n_in %d, in0 %d, out %d, ws %zu; need ws >= %zu); nothing launched\n", n_in, n_in > 0 ? in_sizes[0] : -1, out_size, ws_size, (size_t)WS_END); grid = -1; return; }
        int dev = 0, cus = 0, per_cu = 0;
        if (hipGetDevice(&dev) != hipSuccess || hipDeviceGetAttribute(&cus, hipDeviceAttributeMultiprocessorCount, dev) != hipSuccess) { grid = -1; return; }
        if (hipFuncSetAttribute((const void*)mk_fwd, hipFuncAttributeMaxDynamicSharedMemorySize, LDS_BYTES) != hipSuccess) { fprintf(stderr, "kernel_launch: hipFuncSetAttribute failed\n"); grid = -1; return; }
        if (hipOccupancyMaxActiveBlocksPerMultiprocessor(&per_cu, (const void*)mk_fwd, 512, LDS_BYTES) != hipSuccess || per_cu < 1) { fprintf(stderr, "kernel_launch: occupancy query says %d\n", per_cu); grid = -1; return; }
        grid = cus;
    }
    if (grid < 0) return;
    if (hipMemsetAsync((char*)d_ws + WS_CTL, 0, CTL_ZERO_BYTES, stream) != hipSuccess) return;
    Args a{};
    for (int i = 0; i < 31; ++i) a.in[i] = d_in[i];
    a.out = (float*)d_out; a.ws = (unsigned char*)d_ws;
#if MK_LAUNCH_PER_PHASE
    for (int ph = 0; ph < PH_COUNT; ++ph) { a.ph_lo = ph; a.ph_hi = ph + 1; hipLaunchKernelGGL(mk_fwd, dim3(grid), dim3(512), LDS_BYTES, stream, a); }
#else
    a.ph_lo = 0; a.ph_hi = PH_COUNT; hipLaunchKernelGGL(mk_fwd, dim3(grid), dim3(512), LDS_BYTES, stream, a);
#endif
}
```

```cpp
#include <hip/hip_runtime.h>
#include <cstdio>

#define LAS __attribute__((address_space(3)))
#define DEV __device__ __forceinline__
typedef unsigned short bf16_t;
typedef short bf16x8 __attribute__((ext_vector_type(8)));
typedef float f32x4 __attribute__((ext_vector_type(4)));
typedef float f32x2 __attribute__((ext_vector_type(2)));
typedef unsigned u32x4 __attribute__((ext_vector_type(4)));
typedef unsigned u32x2 __attribute__((ext_vector_type(2)));

#ifndef MK_LAUNCH_PER_PHASE
#define MK_LAUNCH_PER_PHASE 0
#endif

constexpr int NB = 8, T = 4096, D = 1024, NTOK = NB * T, DEPTH = 2;
constexpr int INC = 8960, ZMIXC = 5888, GATEC = 3072;
constexpr int NEXP = 32, DEXP = 512;
constexpr int RMAX = 2 * NTOK + NEXP * 256;
constexpr float NORM_EPS = 1e-6f, RW_GN_EPS = 64e-5f;
constexpr size_t MiB = (size_t)1 << 20;
constexpr size_t BLK_E = (size_t)NTOK * 256;
constexpr size_t BLK_B = BLK_E * 2;

constexpr size_t WS_CTL = 0;
constexpr size_t CTL_ZERO_BYTES = 64 * 1024;
constexpr size_t WS_MODP = 1 * MiB;
constexpr size_t WS_MOD = 4 * MiB;
constexpr size_t WS_LB = 4 * MiB + 512 * 1024;
constexpr size_t WS_HGSIDE = 5 * MiB;
constexpr size_t WS_SEL_E = 8 * MiB;
constexpr size_t WS_SEL_W = WS_SEL_E + 256 * 1024;
constexpr size_t WS_SEL_P = WS_SEL_W + 256 * 1024;
constexpr size_t WS_CNT = WS_SEL_P + 256 * 1024;
constexpr size_t WS_TILEMAP = WS_CNT + 64 * 1024;
constexpr size_t WS_ROWTOK = 9 * MiB;
constexpr size_t WS_RK = 10 * MiB;
constexpr size_t WS_WIN = 16 * MiB;
constexpr size_t WS_BR = 51 * MiB;
constexpr size_t WS_WOUT = 57 * MiB;
constexpr size_t WS_LORAB = 61 * MiB;
constexpr size_t WS_H = 64 * MiB;
constexpr size_t WS_POOL = 128 * MiB;
constexpr size_t WS_END = 640 * MiB;
constexpr int BK_HGQ = 0, BK_HGF = 2, BK_HGI = 4, BK_HGG = 6, BK_RTQ = 8, BK_RTK = 10, BK_RTV = 12, BK_RTG = 14;
constexpr int BK_RWR = 16, BK_RWK = 18, BK_RWV = 20, BK_RWL = 22, BK_LIN = 23, BK_LW = 24, BK_LA = 26, BK_LG = 28, BK_RWO = 30;
constexpr int BK_YF = 16;
constexpr int BK_YB = 24;
constexpr size_t PO_HPERM = 0;
constexpr size_t PO_ACT = 144 * MiB;
constexpr size_t PO_Y2 = 216 * MiB;
constexpr size_t PO_W13 = 360 * MiB;
constexpr size_t PO_W2 = 424 * MiB;

constexpr int LDS_BYTES = 163840;
constexpr int LDS_MISC = 163840 - 64;

DEV float bf2f(unsigned v) { return __uint_as_float(v << 16); }
typedef __bf16 bf16n2 __attribute__((ext_vector_type(2)));
DEV unsigned f2bf(float f) { return (unsigned)__builtin_bit_cast(unsigned short, (__bf16)f); }
DEV unsigned pk2(float lo, float hi) { const f32x2 v = {lo, hi}; return __builtin_bit_cast(unsigned, __builtin_convertvector(v, bf16n2)); }
DEV float sigm(float x) { return __builtin_amdgcn_rcpf(1.f + __expf(-x)); }
DEV float silu(float x) { return x * __builtin_amdgcn_rcpf(1.f + __expf(-x)); }
DEV int opaque_tid() { int t = threadIdx.x; asm volatile("" : "+v"(t)); return t; }
DEV int ld_vec_i(const int* p) { return __hip_atomic_load(p, __ATOMIC_RELAXED, __HIP_MEMORY_SCOPE_AGENT); }
DEV float ld_vec_f(const float* p) { return __hip_atomic_load(p, __ATOMIC_RELAXED, __HIP_MEMORY_SCOPE_AGENT); }
DEV float wave_sum(float v) {
#pragma unroll
    for (int o = 1; o < 64; o <<= 1) v += __shfl_xor(v, o);
    return v;
}
#define LDS_WAIT() asm volatile("s_waitcnt lgkmcnt(0)" ::: "memory")
#define LDS_BARRIER() do { asm volatile("s_waitcnt lgkmcnt(0)" ::: "memory"); __builtin_amdgcn_s_barrier(); asm volatile("" ::: "memory"); } while (0)

#define XB_TMO      128
#define XB_XCNT(j)  (256  + 64 * (j))
#define XB_XSUB(j)  (1280 + 64 * (j))
#define XB_XGEN(j)  (2304 + 64 * (j))
#define XB_TOP      3328
#define XB_TOPGEN   3392
#define XCD_BAR_WORDS 3456
#define XB_SPIN_CAP (1u << 20)

__device__ __forceinline__ unsigned xb_ld(unsigned* p)              { return __hip_atomic_load(p, __ATOMIC_RELAXED, __HIP_MEMORY_SCOPE_AGENT); }
__device__ __forceinline__ unsigned xb_add(unsigned* p, unsigned v) { return __hip_atomic_fetch_add(p, v, __ATOMIC_RELAXED, __HIP_MEMORY_SCOPE_AGENT); }
__device__ __forceinline__ unsigned xb_xcc_id() { return (unsigned)__builtin_amdgcn_s_getreg((3 << 11) | 20) & 0xFu; }
#define XB_SPIN(cond, bar) do { unsigned _sp = 0; while (cond) { __builtin_amdgcn_s_sleep(1); \
    if ((++_sp & 255u) == 0u) { if (xb_ld(&(bar)[XB_TMO])) break; if (_sp > XB_SPIN_CAP) { atomicAdd(&(bar)[XB_TMO], 1u); break; } } } } while (0)

struct XcdBarrier { unsigned* bar; unsigned x; volatile LAS unsigned* st; };

__device__ __forceinline__ XcdBarrier xcd_barrier_post(unsigned* bar, volatile LAS unsigned* st) {
    XcdBarrier b; b.bar = bar; b.x = xb_xcc_id(); b.st = st;
    if (threadIdx.x == 0) (void)xb_add(&bar[XB_XCNT(b.x)], 1u);
    return b;
}
__device__ __forceinline__ void xcd_barrier_complete(unsigned* bar, unsigned x, unsigned& nloc, unsigned& nx) {
    const unsigned G = gridDim.x * gridDim.y * gridDim.z;
    unsigned sum, cnt, mine, sp = 0u;
    for (;;) {
        sum = 0u; cnt = 0u; mine = 0u;
#pragma unroll
        for (unsigned j = 0; j < 16; ++j) { const unsigned c = xb_ld(&bar[XB_XCNT(j)]); sum += c; cnt += (c > 0u) ? 1u : 0u; mine = (j == x) ? c : mine; }
        if (sum == G) break;
        __builtin_amdgcn_s_sleep(1);
        if ((++sp & 255u) == 0u) { if (xb_ld(&bar[XB_TMO])) break; if (sp > XB_SPIN_CAP) { atomicAdd(&bar[XB_TMO], 1u); break; } }
    }
    nloc = mine > 0u ? mine : 1u; nx = cnt > 0u ? cnt : 1u;
}
__device__ __forceinline__ void xcd_barrier(const XcdBarrier& b) {
    asm volatile("s_waitcnt vmcnt(0)" ::: "memory");
    __syncthreads();
    if (threadIdx.x == 0) {
        unsigned* bar = b.bar;
        __builtin_amdgcn_s_waitcnt(0);
        unsigned nloc = b.st[0], nx = b.st[1];
        if (nloc == 0u) { xcd_barrier_complete(bar, b.x, nloc, nx); b.st[0] = nloc; b.st[1] = nx; }
        const unsigned old = xb_add(&bar[XB_XSUB(b.x)], 1u);
        const unsigned gen = old / nloc;
        if (old + 1u == (gen + 1u) * nloc) {
            __builtin_amdgcn_fence(__ATOMIC_RELEASE, "agent");
            asm volatile("s_waitcnt vmcnt(0)" ::: "memory");
            const unsigned og = xb_add(&bar[XB_TOP], 1u);
            const unsigned tg = og / nx;
            if (og + 1u == (tg + 1u) * nx) xb_add(&bar[XB_TOPGEN], 1u);
            else XB_SPIN(xb_ld(&bar[XB_TOPGEN]) == tg, bar);
            __builtin_amdgcn_fence(__ATOMIC_ACQUIRE, "agent");
            xb_add(&bar[XB_XGEN(b.x)], 1u);
            asm volatile("s_waitcnt vmcnt(0)" ::: "memory");
        } else {
            XB_SPIN(xb_ld(&bar[XB_XGEN(b.x)]) == gen, bar);
            __builtin_amdgcn_fence(__ATOMIC_ACQUIRE, "agent");
            asm volatile("s_waitcnt vmcnt(0)" ::: "memory");
        }
    }
    __syncthreads();
}

namespace pg8 {
constexpr int BM = 256, BK = 64, HALF = 128, HTB = HALF * BK * 2, STAGE_BYTES = 8 * HTB, NXCD = 8, WGM = 8;
__host__ __device__ __forceinline__ int lds_byte(int r, int c) { const int st = (r >> 4) * 2 + (c >> 5), rr = r & 15, cc = c & 31, ob = rr * 64 + cc * 2; return st * 1024 + (ob ^ (((ob >> 9) & 1) << 5)); }
__host__ __device__ __forceinline__ void stage_rc(int b, int& R, int& C) { const int st = b / 1024, sb = b % 1024, swz = sb ^ (((sb >> 9) & 1) << 5); R = (st >> 1) * 16 + swz / 64; C = (st & 1) * 32 + (swz % 64) / 2; }
__host__ __device__ __forceinline__ int perm32(int rho) { const int n = rho >> 4, i = rho & 15; return 8 * (i >> 2) + 4 * n + (i & 3); }

struct Unit { int pm, pn, pnb; };
struct Gemm { const bf16_t* A; const bf16_t* Bt; int K; int lda; size_t kblk; size_t seg1, seg2; };

struct DenseOrder {
    static constexpr const int* rowtok = nullptr;
    int nM, nN, nwg, G, c, pnb0;
    __device__ void init(int M, int N, int G_, int c_, int pnb0_) { nM = M / BM; nN = N / BM; nwg = nM * nN; G = G_; c = c_; pnb0 = pnb0_; }
    __device__ bool next(int i, Unit& u) const {
        const long L = (long)i * G + c; if (L >= nwg) return false;
        int wgid = (int)L; { const int q = nwg / NXCD, r = nwg % NXCD, xcd = wgid % NXCD, off = wgid / NXCD; wgid = (xcd < r ? xcd * (q + 1) : r * (q + 1) + (xcd - r) * q) + off; }
        const int nig = WGM * nN, gid = wgid / nig, fm = gid * WGM, gsz = (nM - fm) < WGM ? (nM - fm) : WGM;
        u.pm = fm + ((wgid % nig) % gsz); u.pn = (wgid % nig) / gsz; u.pnb = u.pn + pnb0; return true;
    }
};
struct MoeOrder {
    const int* tilemap; const int* rowtok; int G, c, ntiles;
    __device__ void init(const int* tm, int G_, int c_, const int* rt = nullptr) { tilemap = tm; rowtok = rt; G = G_; c = c_; ntiles = __hip_atomic_load(tm, __ATOMIC_RELAXED, __HIP_MEMORY_SCOPE_AGENT); }
    __device__ bool next(int i, Unit& u) const {
        const int L = i * G + c; if (L >= ntiles * 4) return false;
        const int ti = L >> 2; u.pm = ti; u.pn = L & 3; u.pnb = __hip_atomic_load(tilemap + 1 + ti, __ATOMIC_RELAXED, __HIP_MEMORY_SCOPE_AGENT) * 4 + u.pn; return true;
    }
};

__device__ __forceinline__ unsigned cvt_pk_bf16(float lo, float hi) { return pk2(lo, hi); }

template <bool SEG = false, bool GATH = false, class Epi, class Sched>
__device__ __forceinline__ void gemm_phase(LAS unsigned char* lds, const Gemm g, const Sched& S, const Epi& E) {
    const int tid = opaque_tid(), wid = __builtin_amdgcn_readfirstlane(tid >> 6), lane = tid & 63, wr = wid >> 2, wc = wid & 3, fr = lane & 15, fq = lane >> 4;
    const int K = g.K, nt = K / BK;
    unsigned voffA[2][2], voffN[2][2], voffB[2]; int RA[2], CA[2];
#pragma unroll
    for (int i = 0; i < 2; ++i) { int R, C; stage_rc(tid * 16 + i * 8192, R, C); const int Rb = Epi::PERM ? ((R & ~31) + perm32(R & 31)) : R;
        RA[i] = R; CA[i] = C; voffB[i] = (unsigned)(Rb * K + C) * 2u;
        voffA[0][i] = voffN[0][i] = (unsigned)(R * g.lda + C) * 2u; voffA[1][i] = voffN[1][i] = (unsigned)((R + HALF) * g.lda + C) * 2u; }
    const size_t kstep = (size_t)(BK * 2);
    const size_t hstepA = (size_t)HALF * g.lda * 2, hstepB = (size_t)HALF * K * 2;
    const size_t tstepA = 2 * hstepA, tstepB = 2 * hstepB;
    const size_t kblk = g.kblk;
    const unsigned ldsw = (unsigned)wid * 1024u;
    const int aoff = lds_byte(wr * 64 + fr, fq * 8), boff = lds_byte(wc * 32 + fr, fq * 8);
#define PG8_KOFFA(t) (SEG ? ((((t) >> 3) == 0 ? (size_t)0 : (((t) >> 3) == 1 ? g.seg1 : g.seg2)) + (size_t)(((t) >> 2) & 1) * kblk + (size_t)((t) & 3) * 128) : ((size_t)((t) >> 2) * kblk + (size_t)((t) & 3) * 128))
#define PG8_SA(b, h) (((b) * 2 + (h)) * HTB)
#define PG8_SB(b, h) ((4 + (b) * 2 + (h)) * HTB)
#define PG8_STAGE(bufoff, gbase, voff) do { _Pragma("unroll") for (int _i = 0; _i < 2; ++_i) \
        __builtin_amdgcn_global_load_lds((const unsigned*)((const char*)(gbase) + (voff)[_i]), (LAS unsigned*)(lds + (bufoff) + ldsw + _i * 8192), 16, 0, 0); } while (0)
#define PG8_LDA(dst, b, h) do { _Pragma("unroll") for (int m = 0; m < 4; ++m) _Pragma("unroll") for (int k = 0; k < 2; ++k) dst[m][k] = *(const LAS bf16x8*)(lds + PG8_SA(b, h) + aoff + m * 2048 + k * 1024); } while (0)
#define PG8_LDB(dst, b, h) do { _Pragma("unroll") for (int n = 0; n < 2; ++n) _Pragma("unroll") for (int k = 0; k < 2; ++k) dst[n][k] = *(const LAS bf16x8*)(lds + PG8_SB(b, h) + boff + n * 2048 + k * 1024); } while (0)
#define PG8_MMA(ai, bj, At, Bt) do { __builtin_amdgcn_s_setprio(1); _Pragma("unroll") for (int m = 0; m < 4; ++m) _Pragma("unroll") for (int n = 0; n < 2; ++n) _Pragma("unroll") for (int k = 0; k < 2; ++k) \
        acc[ai][bj][m][n] = __builtin_amdgcn_mfma_f32_16x16x32_bf16(Bt[n][k], At[m][k], acc[ai][bj][m][n], 0, 0, 0); __builtin_amdgcn_s_setprio(0); } while (0)
#define PG8_WAIT_V(n) asm volatile("s_waitcnt vmcnt(" #n ")" ::: "memory")
#define PG8_WAIT_L(n) asm volatile("s_waitcnt lgkmcnt(" #n ")" ::: "memory")
#define PG8_BAR __builtin_amdgcn_s_barrier()
#define PG8_SCHED __builtin_amdgcn_sched_barrier(0)
    Unit cur, nxt; int ui = 0;
    if (!S.next(0, cur)) return;
    f32x4 acc[2][2][4][2];
#pragma unroll
    for (int a = 0; a < 2; ++a)
#pragma unroll
        for (int b = 0; b < 2; ++b)
#pragma unroll
            for (int m = 0; m < 4; ++m)
#pragma unroll
                for (int n = 0; n < 2; ++n) acc[a][b][m][n] = (f32x4){0.f, 0.f, 0.f, 0.f};
    bf16x8 At[4][2], B0[2][2], B1[2][2];
    if constexpr (GATH) {
#pragma unroll
        for (int h_ = 0; h_ < 2; ++h_)
#pragma unroll
            for (int i = 0; i < 2; ++i) voffA[h_][i] = (unsigned)__hip_atomic_load(S.rowtok + cur.pm * BM + h_ * HALF + RA[i], __ATOMIC_RELAXED, __HIP_MEMORY_SCOPE_AGENT) * (unsigned)(g.lda * 2) + (unsigned)CA[i] * 2u; }
    const char* cA = (const char*)g.A + (GATH ? (size_t)0 : (size_t)cur.pm * tstepA); const char* cB = (const char*)g.Bt + (size_t)cur.pnb * tstepB;
    PG8_STAGE(PG8_SB(0, 0), cB, voffB); PG8_STAGE(PG8_SA(0, 0), cA, voffA[0]); PG8_STAGE(PG8_SB(0, 1), cB + hstepB, voffB); PG8_STAGE(PG8_SA(0, 1), cA, voffA[1]);
    if (wr == 1) PG8_BAR;
    PG8_WAIT_V(4); PG8_BAR;
    PG8_STAGE(PG8_SB(1, 0), cB + kstep, voffB); PG8_STAGE(PG8_SA(1, 0), cA + kstep, voffA[0]); PG8_STAGE(PG8_SB(1, 1), cB + hstepB + kstep, voffB);
    PG8_WAIT_V(6); PG8_BAR;
    for (;;) {
        const bool has_next = S.next(ui + 1, nxt);
        if constexpr (GATH) { if (has_next) {
#pragma unroll
            for (int h_ = 0; h_ < 2; ++h_)
#pragma unroll
                for (int i = 0; i < 2; ++i) voffN[h_][i] = (unsigned)__hip_atomic_load(S.rowtok + nxt.pm * BM + h_ * HALF + RA[i], __ATOMIC_RELAXED, __HIP_MEMORY_SCOPE_AGENT) * (unsigned)(g.lda * 2) + (unsigned)CA[i] * 2u; } }
        const char* nA = (has_next && !GATH) ? (const char*)g.A + (size_t)nxt.pm * tstepA : cA; const char* nB = has_next ? (const char*)g.Bt + (size_t)nxt.pnb * tstepB : cB;
        for (int t = 0; t < nt; t += 2) {
            const bool last = (t == nt - 2);
            const char* a1 = cA + PG8_KOFFA(t + 1);
            const char* b1 = cB + (size_t)(t + 1) * kstep; (void)b1;
            const char* a2 = last ? nA : cA + PG8_KOFFA(t + 2); const char* b2 = last ? nB : cB + (size_t)(t + 2) * kstep;
            const char* a3 = a2 + kstep; const char* b3 = b2 + kstep;
            unsigned vo0[2], vo1[2];
#pragma unroll
            for (int i = 0; i < 2; ++i) { vo0[i] = (GATH && last) ? voffN[0][i] : voffA[0][i]; vo1[i] = (GATH && last) ? voffN[1][i] : voffA[1][i]; }
            PG8_LDB(B0, 0, 0); PG8_SCHED; PG8_LDA(At, 0, 0); PG8_STAGE(PG8_SA(1, 1), a1, voffA[1]);
            PG8_WAIT_L(8); PG8_BAR; PG8_WAIT_L(0); PG8_MMA(0, 0, At, B0); PG8_BAR; PG8_SCHED;
            PG8_LDB(B1, 0, 1); PG8_STAGE(PG8_SB(0, 0), b2, voffB);
            PG8_BAR; PG8_WAIT_L(0); PG8_MMA(0, 1, At, B1); PG8_BAR;
            PG8_LDA(At, 0, 1); PG8_STAGE(PG8_SA(0, 0), a2, vo0);
            PG8_BAR; PG8_WAIT_L(0); PG8_MMA(1, 0, At, B0); PG8_BAR; PG8_SCHED;
            PG8_STAGE(PG8_SB(0, 1), b2 + hstepB, voffB);
            PG8_WAIT_V(6); PG8_BAR; PG8_MMA(1, 1, At, B1); PG8_BAR;
            PG8_LDB(B0, 1, 0); PG8_SCHED; PG8_LDA(At, 1, 0); PG8_STAGE(PG8_SA(0, 1), a2, vo1);
            PG8_WAIT_L(8); PG8_BAR; PG8_WAIT_L(0); PG8_MMA(0, 0, At, B0); PG8_BAR; PG8_SCHED;
            PG8_LDB(B1, 1, 1); PG8_STAGE(PG8_SB(1, 0), b3, voffB);
            PG8_BAR; PG8_WAIT_L(0); PG8_MMA(0, 1, At, B1); PG8_BAR;
            PG8_LDA(At, 1, 1); PG8_STAGE(PG8_SA(1, 0), a3, vo0);
            PG8_BAR; PG8_WAIT_L(0); PG8_MMA(1, 0, At, B0); PG8_BAR; PG8_SCHED;
            PG8_STAGE(PG8_SB(1, 1), b3 + hstepB, voffB);
            PG8_WAIT_V(6); PG8_BAR; PG8_MMA(1, 1, At, B1); PG8_BAR;
            if constexpr (SEG) { if (t == 6 || t == 14) E.rescale(acc, cur, t >> 3, wr, wc, fr, fq); }
        }
        E(acc, cur, wr, wc, fr, fq);
        if (!has_next) break;
#pragma unroll
        for (int a = 0; a < 2; ++a)
#pragma unroll
            for (int b = 0; b < 2; ++b)
#pragma unroll
                for (int m = 0; m < 4; ++m)
#pragma unroll
                    for (int n = 0; n < 2; ++n) acc[a][b][m][n] = (f32x4){0.f, 0.f, 0.f, 0.f};
        cur = nxt; cA = nA; cB = nB; ++ui;
        if constexpr (GATH) {
#pragma unroll
            for (int h_ = 0; h_ < 2; ++h_)
#pragma unroll
                for (int i = 0; i < 2; ++i) voffA[h_][i] = voffN[h_][i]; }
    }
    PG8_WAIT_V(0);
    if (wr == 0) PG8_BAR;
    PG8_BAR;
#undef PG8_KOFFA
#undef PG8_SA
#undef PG8_SB
#undef PG8_STAGE
#undef PG8_LDA
#undef PG8_LDB
#undef PG8_MMA
#undef PG8_WAIT_V
#undef PG8_WAIT_L
#undef PG8_BAR
#undef PG8_SCHED
}

template <int MAP, int ACT> struct EpiBlk {
    static constexpr bool PERM = true;
    bf16_t* pool;
    __device__ __forceinline__ int bmap(int pn) const {
        if (MAP == 0) return pn;
        if (MAP == 1) return BK_LW + pn;
        return pn < 4 ? pn : (pn < 10 ? pn + 2 : pn + 4);
    }
    __device__ __forceinline__ void operator()(const f32x4 (&acc)[2][2][4][2], const Unit& u, int wr, int wc, int fr, int fq) const {
        bf16_t* base = pool + (size_t)bmap(u.pn) * BLK_E;
        const int row0 = u.pm * BM + wr * 64 + fr, col0 = wc * 32 + 8 * fq;
#pragma unroll
        for (int ai = 0; ai < 2; ++ai)
#pragma unroll
            for (int m = 0; m < 4; ++m) { bf16_t* rowp = base + (size_t)(row0 + ai * HALF + m * 16) * 256 + col0;
#pragma unroll
                for (int bj = 0; bj < 2; ++bj) { f32x4 v0 = acc[ai][bj][m][0], v1 = acc[ai][bj][m][1];
                    if (ACT == 1) {
#pragma unroll
                        for (int j = 0; j < 4; ++j) { v0[j] = sigm(v0[j]); v1[j] = sigm(v1[j]); } }
                    u32x4 w; w.x = cvt_pk_bf16(v0[0], v0[1]); w.y = cvt_pk_bf16(v0[2], v0[3]); w.z = cvt_pk_bf16(v1[0], v1[1]); w.w = cvt_pk_bf16(v1[2], v1[3]);
                    *(u32x4*)(rowp + bj * HALF) = w; } }
    }
};
struct EpiRowBf16 {
    static constexpr bool PERM = true;
    bf16_t* O; int ldc;
    __device__ __forceinline__ void operator()(const f32x4 (&acc)[2][2][4][2], const Unit& u, int wr, int wc, int fr, int fq) const {
        const int row0 = u.pm * BM + wr * 64 + fr, col0 = u.pn * BM + wc * 32 + 8 * fq;
#pragma unroll
        for (int ai = 0; ai < 2; ++ai)
#pragma unroll
            for (int m = 0; m < 4; ++m) { bf16_t* rowp = O + (size_t)(row0 + ai * HALF + m * 16) * ldc + col0;
#pragma unroll
                for (int bj = 0; bj < 2; ++bj) { const f32x4 v0 = acc[ai][bj][m][0], v1 = acc[ai][bj][m][1];
                    u32x4 w; w.x = cvt_pk_bf16(v0[0], v0[1]); w.y = cvt_pk_bf16(v0[2], v0[3]); w.z = cvt_pk_bf16(v1[0], v1[1]); w.w = cvt_pk_bf16(v1[2], v1[3]);
                    *(u32x4*)(rowp + bj * HALF) = w; } }
    }
};
struct EpiSwiglu {
    static constexpr bool PERM = true;
    bf16_t* O;
    __device__ __forceinline__ void operator()(const f32x4 (&acc)[2][2][4][2], const Unit& u, int wr, int wc, int fr, int fq) const {
        const int row0 = u.pm * BM + wr * 64 + fr, col0 = u.pn * HALF + wc * 32 + 8 * fq;
#pragma unroll
        for (int ai = 0; ai < 2; ++ai)
#pragma unroll
            for (int m = 0; m < 4; ++m) { bf16_t* rowp = O + (size_t)(row0 + ai * HALF + m * 16) * DEXP + col0;
                f32x4 v0, v1;
#pragma unroll
                for (int j = 0; j < 4; ++j) { v0[j] = silu(acc[ai][0][m][0][j]) * acc[ai][1][m][0][j]; v1[j] = silu(acc[ai][0][m][1][j]) * acc[ai][1][m][1][j]; }
                u32x4 w; w.x = cvt_pk_bf16(v0[0], v0[1]); w.y = cvt_pk_bf16(v0[2], v0[3]); w.z = cvt_pk_bf16(v1[0], v1[1]); w.w = cvt_pk_bf16(v1[2], v1[3]);
                *(u32x4*)rowp = w; }
    }
};
template <int MODE> struct EpiBranch {
    static constexpr bool PERM = true;
    float* Y; const bf16_t* pool; bf16_t* yb; int gt0;
    __device__ __forceinline__ int gmap(int t) const { return t < 4 ? t : (t < 10 ? t + 2 : t + 4); }
    __device__ __forceinline__ void operator()(const f32x4 (&acc)[2][2][4][2], const Unit& u, int wr, int wc, int fr, int fq) const {
        const bf16_t* gbase = pool + (size_t)gmap(gt0 + u.pn) * BLK_E;
        const int row0 = u.pm * BM + wr * 64 + fr, colb = wc * 32 + 8 * fq;
#pragma unroll
        for (int ai = 0; ai < 2; ++ai)
#pragma unroll
            for (int m = 0; m < 4; ++m) { const size_t row = (size_t)(row0 + ai * HALF + m * 16);
#pragma unroll
                for (int bj = 0; bj < 2; ++bj) { const int cb = colb + bj * HALF;
                    const u32x4 gw = *(const u32x4*)(gbase + row * 256 + cb);
                    f32x4 g0, g1; g0[0] = bf2f(gw.x & 0xffffu); g0[1] = bf2f(gw.x >> 16); g0[2] = bf2f(gw.y & 0xffffu); g0[3] = bf2f(gw.y >> 16);
                    g1[0] = bf2f(gw.z & 0xffffu); g1[1] = bf2f(gw.z >> 16); g1[2] = bf2f(gw.w & 0xffffu); g1[3] = bf2f(gw.w >> 16);
                    float* yp = Y + row * D + u.pn * BM + cb;
                    f32x4 v0 = acc[ai][bj][m][0] * g0, v1 = acc[ai][bj][m][1] * g1;
                    if (MODE != 0) { v0 += *(const f32x4*)yp; v1 += *(const f32x4*)(yp + 4); }
                    if (MODE != 2) { *(f32x4*)yp = v0; *(f32x4*)(yp + 4) = v1; }
                    else { u32x4 w; w.x = cvt_pk_bf16(v0[0], v0[1]); w.y = cvt_pk_bf16(v0[2], v0[3]); w.z = cvt_pk_bf16(v1[0], v1[1]); w.w = cvt_pk_bf16(v1[2], v1[3]);
                        *(u32x4*)(yb + (size_t)u.pn * BLK_E + row * 256 + cb) = w; } } }
    }
};
struct EpiHorner {
    static constexpr bool PERM = true;
    const bf16_t* pool; bf16_t* yb;
    __device__ __forceinline__ int gmap(int t) const { return t < 4 ? t : (t < 10 ? t + 2 : t + 4); }
    __device__ __forceinline__ void rescale(f32x4 (&acc)[2][2][4][2], const Unit& u, int seg, int wr, int wc, int fr, int fq) const {
        const bf16_t* ga = pool + (size_t)gmap(seg * 4 + u.pn) * BLK_E; const bf16_t* gb = pool + (size_t)gmap(seg * 4 + 4 + u.pn) * BLK_E;
        const int row0 = u.pm * BM + wr * 64 + fr, colb = wc * 32 + 8 * fq;
#pragma unroll
        for (int ai = 0; ai < 2; ++ai)
#pragma unroll
            for (int m = 0; m < 4; ++m) { const size_t row = (size_t)(row0 + ai * HALF + m * 16);
#pragma unroll
                for (int bj = 0; bj < 2; ++bj) { const int cb = colb + bj * HALF;
                    const u32x4 wa = *(const u32x4*)(ga + row * 256 + cb), wb = *(const u32x4*)(gb + row * 256 + cb);
                    const unsigned ua[4] = {wa.x, wa.y, wa.z, wa.w}, ub[4] = {wb.x, wb.y, wb.z, wb.w};
#pragma unroll
                    for (int j = 0; j < 4; ++j) {
                        acc[ai][bj][m][0][j] *= bf2f((ua[j >> 1] >> ((j & 1) * 16)) & 0xffffu) * __builtin_amdgcn_rcpf(bf2f((ub[j >> 1] >> ((j & 1) * 16)) & 0xffffu));
                        acc[ai][bj][m][1][j] *= bf2f((ua[2 + (j >> 1)] >> ((j & 1) * 16)) & 0xffffu) * __builtin_amdgcn_rcpf(bf2f((ub[2 + (j >> 1)] >> ((j & 1) * 16)) & 0xffffu)); } } }
    }
    __device__ __forceinline__ void operator()(const f32x4 (&acc)[2][2][4][2], const Unit& u, int wr, int wc, int fr, int fq) const {
        const bf16_t* gc = pool + (size_t)gmap(8 + u.pn) * BLK_E;
        const int row0 = u.pm * BM + wr * 64 + fr, colb = wc * 32 + 8 * fq;
#pragma unroll
        for (int ai = 0; ai < 2; ++ai)
#pragma unroll
            for (int m = 0; m < 4; ++m) { const size_t row = (size_t)(row0 + ai * HALF + m * 16);
#pragma unroll
                for (int bj = 0; bj < 2; ++bj) { const int cb = colb + bj * HALF;
                    const u32x4 gw = *(const u32x4*)(gc + row * 256 + cb);
                    f32x4 g0, g1; g0[0] = bf2f(gw.x & 0xffffu); g0[1] = bf2f(gw.x >> 16); g0[2] = bf2f(gw.y & 0xffffu); g0[3] = bf2f(gw.y >> 16);
                    g1[0] = bf2f(gw.z & 0xffffu); g1[1] = bf2f(gw.z >> 16); g1[2] = bf2f(gw.w & 0xffffu); g1[3] = bf2f(gw.w >> 16);
                    const f32x4 v0 = acc[ai][bj][m][0] * g0, v1 = acc[ai][bj][m][1] * g1;
                    u32x4 w; w.x = cvt_pk_bf16(v0[0], v0[1]); w.y = cvt_pk_bf16(v0[2], v0[3]); w.z = cvt_pk_bf16(v1[0], v1[1]); w.w = cvt_pk_bf16(v1[2], v1[3]);
                    *(u32x4*)(yb + (size_t)u.pn * BLK_E + row * 256 + cb) = w; } }
    }
};
template <bool F32IN> struct EpiResid {
    static constexpr bool PERM = true;
    const float* xin32; bf16_t* xb; const float* gate;
    __device__ __forceinline__ void operator()(const f32x4 (&acc)[2][2][4][2], const Unit& u, int wr, int wc, int fr, int fq) const {
        const int row0 = u.pm * BM + wr * 64 + fr, col0 = u.pn * BM + wc * 32 + 8 * fq;
        const float* gp = gate + (size_t)(u.pm / 16) * 6144 + col0;
        f32x4 gv[2][2];
#pragma unroll
        for (int bj = 0; bj < 2; ++bj)
#pragma unroll
            for (int n = 0; n < 2; ++n) gv[bj][n] = *(const f32x4*)(gp + bj * HALF + 4 * n);
#pragma unroll
        for (int ai = 0; ai < 2; ++ai)
#pragma unroll
            for (int m = 0; m < 4; ++m) { const size_t row = (size_t)(row0 + ai * HALF + m * 16);
#pragma unroll
                for (int bj = 0; bj < 2; ++bj) { const int col = col0 + bj * HALF;
                    f32x4 x0, x1;
                    if (F32IN) { x0 = *(const f32x4*)(xin32 + row * D + col); x1 = *(const f32x4*)(xin32 + row * D + col + 4); }
                    else { const u32x4 w = *(const u32x4*)(xb + row * (2 * D) + col);
                        x0 = (f32x4){bf2f(w.x & 0xffffu), bf2f(w.x >> 16), bf2f(w.y & 0xffffu), bf2f(w.y >> 16)}; x1 = (f32x4){bf2f(w.z & 0xffffu), bf2f(w.z >> 16), bf2f(w.w & 0xffffu), bf2f(w.w >> 16)}; }
                    x0 += gv[bj][0] * acc[ai][bj][m][0]; x1 += gv[bj][1] * acc[ai][bj][m][1];
                    u32x4 o; o.x = cvt_pk_bf16(x0[0], x0[1]); o.y = cvt_pk_bf16(x0[2], x0[3]); o.z = cvt_pk_bf16(x1[0], x1[1]); o.w = cvt_pk_bf16(x1[2], x1[3]);
                    *(u32x4*)(xb + row * (2 * D) + col) = o; } }
    }
};
}

struct Args { const void* in[31]; float* out; unsigned char* ws; int ph_lo, ph_hi; };
enum { I_X = 0, I_C, I_POS, I_ADAW, I_ADAB, I_N1G, I_N2G, I_WIN, I_LBT, I_HGNW, I_MU, I_W0, I_W2, I_A0, I_A2, I_G2, I_KK, I_KA, I_RK, I_LNW, I_LNB,
       I_BRHG, I_BRRET, I_BRRW, I_WOUT, I_RG, I_RE, I_MW1, I_MW3, I_MW2, I_FG };
typedef const __attribute__((address_space(4))) Args KA;
#define FIN(i) ((const float*)a.in[i])
DEV bf16_t* pool_blk(KA& a, int blk) { return (bf16_t*)(a.ws + WS_POOL) + (size_t)blk * BLK_E; }

#define DPP_ADD(x, ctrl) x += __builtin_bit_cast(float, __builtin_amdgcn_update_dpp(__builtin_bit_cast(int, x), __builtin_bit_cast(int, x), ctrl, 0xF, 0xF, false))
DEV float row16_sum(float x) { DPP_ADD(x, 0xB1); DPP_ADD(x, 0x4E); DPP_ADD(x, 0x141); DPP_ADD(x, 0x140); return x; }
DEV float row8_sum(float x) { DPP_ADD(x, 0xB1); DPP_ADD(x, 0x4E); DPP_ADD(x, 0x141); return x; }

DEV void transpose_item(const float* W, int N, bf16_t* WT, int ldt, int dst_row0, LAS float* scr, int k0, int n0, int lane) {
#pragma unroll
    for (int i = 0; i < 8; ++i) { const int kk = 8 * i + (lane >> 3), n4 = (lane & 7) * 4;
        const f32x4 v = *(const f32x4*)(W + (size_t)(k0 + kk) * N + n0 + n4);
        scr[kk * 33 + n4] = v[0]; scr[kk * 33 + n4 + 1] = v[1]; scr[kk * 33 + n4 + 2] = v[2]; scr[kk * 33 + n4 + 3] = v[3]; }
    LDS_WAIT(); asm volatile("" ::: "memory");
    const int c = lane & 7;
#pragma unroll
    for (int j = 0; j < 4; ++j) { const int n = (lane >> 3) + 8 * j; const LAS float* s = scr + (8 * c) * 33 + n;
        u32x4 o; o.x = pk2(s[0 * 33], s[1 * 33]); o.y = pk2(s[2 * 33], s[3 * 33]); o.z = pk2(s[4 * 33], s[5 * 33]); o.w = pk2(s[6 * 33], s[7 * 33]);
        *(u32x4*)(WT + (size_t)(dst_row0 + n) * ldt + k0 + 8 * c) = o; }
    LDS_WAIT(); asm volatile("" ::: "memory");
}

DEV void phase_prologue(KA& a, LAS unsigned char* lds) {
    const int tid = opaque_tid(), lane = tid & 63, wave = tid >> 6, G = gridDim.x, wg = blockIdx.x;
    LAS float* scr = (LAS float*)(lds + wave * 8448);
    const int gw = wg * 8 + wave, NGW = G * 8;
    for (int it = gw; it < 2 * 5760; it += NGW) {
        const int l = it / 5760, r = it % 5760;
        if (r < 4480) { const int kb = r / 280, nb = r % 280;
            transpose_item(FIN(I_WIN) + (size_t)l * 1024 * INC, INC, (bf16_t*)(a.ws + WS_WIN) + (size_t)l * INC * 1024, 1024, nb * 32, scr, kb * 64, nb * 32, lane); }
        else if (r < 4480 + 768) { const int r2 = r - 4480, br = r2 / 256, r3 = r2 % 256, kb = r3 / 32, nb = r3 % 32;
            const float* W = (br == 0 ? FIN(I_BRHG) : (br == 1 ? FIN(I_BRRET) : FIN(I_BRRW))) + (size_t)l * 512 * 1024;
            transpose_item(W, 1024, (bf16_t*)(a.ws + WS_BR) + (size_t)l * 1024 * 1536 + br * 512, 1536, nb * 32, scr, kb * 64, nb * 32, lane); }
        else { const int r4 = r - 5248, kb = r4 / 32, nb = r4 % 32;
            transpose_item(FIN(I_WOUT) + (size_t)l * 1024 * 1024, 1024, (bf16_t*)(a.ws + WS_WOUT) + (size_t)l * 1024 * 1024, 1024, nb * 32, scr, kb * 64, nb * 32, lane); }
    }
    {
        unsigned* LB = (unsigned*)(a.ws + WS_LORAB);
        for (int p = wg * 512 + tid; p < 2 * 1536 * 128; p += G * 512) {
            const int l = p / (1536 * 128), rem = p % (1536 * 128), n = rem / 128, k = (rem % 128) * 2;
            float v0 = 0.f, v1 = 0.f;
            if (n < 512) { if (k < 64) { v0 = FIN(I_W2)[((size_t)l * 64 + k) * 512 + n]; v1 = FIN(I_W2)[((size_t)l * 64 + k + 1) * 512 + n]; } }
            else if (n < 1024) { if (k >= 64 && k < 128) { v0 = FIN(I_A2)[((size_t)l * 64 + k - 64) * 512 + n - 512]; v1 = FIN(I_A2)[((size_t)l * 64 + k - 63) * 512 + n - 512]; } }
            else { if (k >= 128) { v0 = FIN(I_G2)[((size_t)l * 128 + k - 128) * 512 + n - 1024]; v1 = FIN(I_G2)[((size_t)l * 128 + k - 127) * 512 + n - 1024]; } }
            LB[p] = pk2(v0, v1);
        }
    }
    if (wg == 0) {
        float* LBv = (float*)(a.ws + WS_LB);
        for (int i = tid; i < 512; i += 512) { const float t0 = FIN(I_LBT)[i], t1 = FIN(I_LBT)[512 + i]; LBv[i] = 0.f; LBv[512 + i] = 1.f / (1.f + __expf(t0 - t1)); }
    }
    __syncthreads();
    {
        LAS float* cond = (LAS float*)lds;
        LAS float* red = (LAS float*)(lds + 4096);
        float* modp = (float*)(a.ws + WS_MODP);
        for (int item = wg; item < 384; item += G) {
            const int l = item / 192, s = (item % 192) / 24, cb = item % 24;
            for (int i = tid; i < 1024; i += 512) { const int b = i >> 7, kk = i & 127; cond[i] = silu(FIN(I_C)[b * 1024 + s * 128 + kk]); }
            __syncthreads();
            const int colin = tid & 255, half = tid >> 8, col = cb * 256 + colin;
            float acc[8];
#pragma unroll
            for (int b = 0; b < 8; ++b) acc[b] = 0.f;
            const float* Wp = FIN(I_ADAW) + ((size_t)l * 1024 + s * 128 + half * 64) * 6144 + col;
#pragma unroll 16
            for (int kk = 0; kk < 64; ++kk) { const float w = Wp[(size_t)kk * 6144];
#pragma unroll
                for (int b = 0; b < 8; ++b) acc[b] += cond[b * 128 + half * 64 + kk] * w; }
            if (half == 1) {
#pragma unroll
                for (int b = 0; b < 8; ++b) red[b * 256 + colin] = acc[b]; }
            __syncthreads();
            if (half == 0) {
#pragma unroll
                for (int b = 0; b < 8; ++b) modp[((size_t)(s * 2 + l) * 8 + b) * 6144 + col] = acc[b] + red[b * 256 + colin]; }
            __syncthreads();
        }
    }
}

template <int MODE> DEV void phase_norm(KA& a, LAS unsigned char* lds, int l) {
    const int tid = opaque_tid(), lane = tid & 63, wave = tid >> 6, G = gridDim.x, wg = blockIdx.x;
    LAS float* sc = (LAS float*)lds; LAS float* sh = sc + 1024; LAS float* gn = sc + 2048;
    LAS float* g2 = sc + 3072;
    LAS float* Wr = sc + 3072;
    LAS int* hist = (LAS int*)(lds + 12288 + 147456);
    const float* modp = (const float*)(a.ws + WS_MODP);
    float* mod = (float*)(a.ws + WS_MOD);
    if (MODE == 0) {
        for (int i = wg * 512 + tid; i < 2 * 8 * 6144; i += G * 512) { const int ll = i / (8 * 6144), rem = i % (8 * 6144), b = rem / 6144, j = rem % 6144;
            float s = FIN(I_ADAB)[ll * 6144 + j];
#pragma unroll
            for (int k = 0; k < 8; ++k) s += modp[((size_t)(k * 2 + ll) * 8 + b) * 6144 + j];
            mod[i] = s; }
    }
    if (MODE == 2) {
        LAS float* scr = (LAS float*)(lds + wave * 8448);
        const int gw = wg * 8 + wave, NGW = G * 8;
        bf16_t* W13T = (bf16_t*)(a.ws + WS_POOL + PO_W13); bf16_t* W2T = (bf16_t*)(a.ws + WS_POOL + PO_W2);
        for (int it = gw; it < NEXP * 768; it += NGW) {
            const int e = it / 768, r = it % 768;
            if (r < 512) { const int w3 = r / 256, r2 = r % 256, kb = r2 / 16, nb = r2 % 16, n0 = nb * 32;
                const float* W = (w3 ? FIN(I_MW3) : FIN(I_MW1)) + ((size_t)l * NEXP + e) * 1024 * 512;
                transpose_item(W, 512, W13T + (size_t)e * 1024 * 1024, 1024, (n0 / 128) * 256 + w3 * 128 + (n0 % 128), scr, kb * 64, n0, lane); }
            else { const int r2 = r - 512, kb = r2 / 32, nb = r2 % 32;
                transpose_item(FIN(I_MW2) + ((size_t)l * NEXP + e) * 512 * 1024, 1024, W2T + (size_t)e * 1024 * 512, 512, nb * 32, scr, kb * 64, nb * 32, lane); }
        }
        __syncthreads();
        for (int i = tid; i < 1024 * 4; i += 512) { const int k = i >> 2, o = i & 3; Wr[o * 1024 + k] = FIN(I_RG)[(size_t)l * 4096 + i]; }
        for (int i = tid; i < 1024 * 32; i += 512) { const int k = i >> 5, o = i & 31; Wr[(4 + o) * 1024 + k] = FIN(I_RE)[(size_t)l * 32768 + i]; }
        if (tid < 32) hist[tid] = 0;
    }
    const float* xsrc = (MODE == 0) ? FIN(I_X) : a.out;
    const bf16_t* Y2 = (const bf16_t*)(a.ws + WS_POOL + PO_Y2);
    const int* selp = (const int*)(a.ws + WS_SEL_P); const float* selw = (const float*)(a.ws + WS_SEL_W);
    bf16_t* H = (bf16_t*)(a.ws + WS_H);
    for (int grp = wg; grp < NTOK / 128; grp += G) {
        const int b = grp / 32;
        __syncthreads();
        for (int j = tid; j < 1024; j += 512) {
            float scale, shift, gain;
            if (MODE == 0) { float s0 = FIN(I_ADAB)[l * 6144 + j], s1 = FIN(I_ADAB)[l * 6144 + 1024 + j];
#pragma unroll
                for (int k = 0; k < 8; ++k) { s0 += modp[((size_t)(k * 2 + l) * 8 + b) * 6144 + j]; s1 += modp[((size_t)(k * 2 + l) * 8 + b) * 6144 + 1024 + j]; }
                shift = s0; scale = s1; gain = FIN(I_N1G)[l * 1024 + j]; }
            else if (MODE == 1) { shift = mod[((size_t)l * 8 + b) * 6144 + j]; scale = mod[((size_t)l * 8 + b) * 6144 + 1024 + j]; gain = FIN(I_N1G)[l * 1024 + j]; }
            else if (MODE == 2) { shift = mod[((size_t)l * 8 + b) * 6144 + 3072 + j]; scale = mod[((size_t)l * 8 + b) * 6144 + 4096 + j]; gain = FIN(I_N2G)[l * 1024 + j]; }
            else { shift = 0.f; scale = 0.f; gain = FIN(I_FG)[j]; }
            sc[j] = 1.f + scale; sh[j] = shift; gn[j] = gain;
            if (MODE == 1 || MODE == 3) { const int lp = (MODE == 1) ? l - 1 : DEPTH - 1; g2[j] = mod[((size_t)lp * 8 + b) * 6144 + 5120 + j]; }
        }
        __syncthreads();
        const bf16_t* xb = (const bf16_t*)a.out;
#define LOADX(dst, n_) do { if (MODE == 0) { _Pragma("unroll") for (int j = 0; j < 4; ++j) dst[j] = *(const f32x4*)(xsrc + (size_t)(n_) * D + 256 * j + 4 * lane); } \
            else { _Pragma("unroll") for (int j = 0; j < 4; ++j) { const u32x2 w_ = *(const u32x2*)(xb + (size_t)(n_) * (2 * D) + 256 * j + 4 * lane); \
                dst[j] = (f32x4){bf2f(w_.x & 0xffffu), bf2f(w_.x >> 16), bf2f(w_.y & 0xffffu), bf2f(w_.y >> 16)}; } } } while (0)
        constexpr int NBT = (MODE == 0) ? 4 : 2;
        for (int tb = 0; tb < 16; tb += NBT) {
        f32x4 vb_[NBT][4]; int pb0[NBT] = {}, pb1[NBT] = {}; float wb0[NBT] = {}, wb1[NBT] = {}; u32x2 yb0[NBT][4], yb1[NBT][4];
#pragma unroll
        for (int u = 0; u < NBT; ++u) { const int n_ = grp * 128 + wave * 16 + tb + u; LOADX(vb_[u], n_);
            if (MODE == 1 || MODE == 3) { pb0[u] = ld_vec_i(selp + 2 * n_); pb1[u] = ld_vec_i(selp + 2 * n_ + 1); wb0[u] = ld_vec_f(selw + 2 * n_); wb1[u] = ld_vec_f(selw + 2 * n_ + 1); } }
        if (MODE == 1 || MODE == 3) {
#pragma unroll
            for (int u = 0; u < NBT; ++u)
#pragma unroll
                for (int j = 0; j < 4; ++j) { const int c = 256 * j + 4 * lane; yb0[u][j] = *(const u32x2*)(Y2 + (size_t)pb0[u] * D + c); yb1[u][j] = *(const u32x2*)(Y2 + (size_t)pb1[u] * D + c); } }
#pragma unroll
        for (int u = 0; u < NBT; ++u) {
            const int ti = tb + u; (void)ti;
            const int n = grp * 128 + wave * 16 + tb + u;
            f32x4 v[4];
#pragma unroll
            for (int j = 0; j < 4; ++j) v[j] = vb_[u][j];
            if (MODE == 1 || MODE == 3) {
                const float w0 = wb0[u], w1 = wb1[u];
#pragma unroll
                for (int j = 0; j < 4; ++j) { const int c = 256 * j + 4 * lane;
                    const u32x2 y0 = yb0[u][j], y1 = yb1[u][j];
                    const f32x4 gg = *(const LAS f32x4*)(g2 + c);
                    v[j][0] += gg[0] * (w0 * bf2f(y0.x & 0xffffu) + w1 * bf2f(y1.x & 0xffffu));
                    v[j][1] += gg[1] * (w0 * bf2f(y0.x >> 16) + w1 * bf2f(y1.x >> 16));
                    v[j][2] += gg[2] * (w0 * bf2f(y0.y & 0xffffu) + w1 * bf2f(y1.y & 0xffffu));
                    v[j][3] += gg[3] * (w0 * bf2f(y0.y >> 16) + w1 * bf2f(y1.y >> 16));
                    if (MODE == 1) { u32x2 o_; o_.x = pk2(v[j][0], v[j][1]); o_.y = pk2(v[j][2], v[j][3]); *(u32x2*)((bf16_t*)a.out + (size_t)n * (2 * D) + c) = o_; } }
            }
            float ss = 0.f;
#pragma unroll
            for (int j = 0; j < 4; ++j) ss += (v[j][0] * v[j][0] + v[j][1] * v[j][1]) + (v[j][2] * v[j][2] + v[j][3] * v[j][3]);
            ss = wave_sum(ss);
            const float r = __builtin_amdgcn_rsqf(ss * (1.f / D) + NORM_EPS);
#pragma unroll
            for (int j = 0; j < 4; ++j) { const int c = 256 * j + 4 * lane;
                const f32x4 gg = *(const LAS f32x4*)(gn + c), s1 = *(const LAS f32x4*)(sc + c), s0 = *(const LAS f32x4*)(sh + c);
                v[j] = v[j] * r * gg * s1 + s0;
                if (MODE == 3) *(f32x4*)(a.out + (size_t)n * D + c) = v[j];
                else { u32x2 o; o.x = pk2(v[j][0], v[j][1]); o.y = pk2(v[j][2], v[j][3]); *(u32x2*)(H + (size_t)n * D + c) = o; } }
            if (MODE == 2) {
#define RT_RED(X, N_) do { \
                _Pragma("unroll") for (int o = 0; o < N_; ++o) X[o] += __builtin_bit_cast(float, __builtin_amdgcn_update_dpp(0, __builtin_bit_cast(int, X[o]), 0xB1, 0xF, 0xF, true)); \
                _Pragma("unroll") for (int o = 0; o < N_; ++o) X[o] += __builtin_bit_cast(float, __builtin_amdgcn_update_dpp(0, __builtin_bit_cast(int, X[o]), 0x4E, 0xF, 0xF, true)); \
                _Pragma("unroll") for (int o = 0; o < N_; ++o) X[o] += __builtin_bit_cast(float, __builtin_amdgcn_update_dpp(0, __builtin_bit_cast(int, X[o]), 0x141, 0xF, 0xF, true)); \
                _Pragma("unroll") for (int o = 0; o < N_; ++o) X[o] += __builtin_bit_cast(float, __builtin_amdgcn_update_dpp(0, __builtin_bit_cast(int, X[o]), 0x140, 0xF, 0xF, true)); \
                _Pragma("unroll") for (int o = 0; o < N_; ++o) X[o] += __builtin_bit_cast(float, __builtin_amdgcn_update_dpp(0, __builtin_bit_cast(int, X[o]), 0x142, 0xA, 0xF, false)); \
                _Pragma("unroll") for (int o = 0; o < N_; ++o) X[o] += __builtin_bit_cast(float, __builtin_amdgcn_update_dpp(0, __builtin_bit_cast(int, X[o]), 0x143, 0xC, 0xF, false)); \
                _Pragma("unroll") for (int o = 0; o < N_; ++o) X[o] = __builtin_bit_cast(float, __builtin_amdgcn_readlane(__builtin_bit_cast(int, X[o]), 63)); } while (0)
                float L[4];
#pragma unroll
                for (int o = 0; o < 4; ++o) { float p = 0.f;
#pragma unroll
                    for (int j = 0; j < 4; ++j) { const f32x4 w = *(const LAS f32x4*)(Wr + o * 1024 + 256 * j + 4 * lane); p += (v[j][0] * w[0] + v[j][1] * w[1]) + (v[j][2] * w[2] + v[j][3] * w[3]); }
                    L[o] = p; }
                RT_RED(L, 4);
                int gi = 0; float gm = L[0];
#pragma unroll
                for (int o = 1; o < 4; ++o) if (L[o] > gm) { gm = L[o]; gi = o; }
                float gs = 0.f;
#pragma unroll
                for (int o = 0; o < 4; ++o) gs += __expf(L[o] - gm);
                const float gw_ = 1.f / gs;
                float le[8];
                { const LAS float* We = Wr + (4 + gi * 8) * 1024;
#pragma unroll
                  for (int o = 0; o < 8; ++o) { float p = 0.f;
#pragma unroll
                    for (int j = 0; j < 4; ++j) { const f32x4 w = *(const LAS f32x4*)(We + o * 1024 + 256 * j + 4 * lane); p += (v[j][0] * w[0] + v[j][1] * w[1]) + (v[j][2] * w[2] + v[j][3] * w[3]); }
                    le[o] = p; } }
                RT_RED(le, 8);
#undef RT_RED
                int i0 = 0; float m0 = le[0];
#pragma unroll
                for (int j = 1; j < 8; ++j) if (le[j] > m0) { m0 = le[j]; i0 = j; }
                int i1 = -1; float m1 = -3.0e38f;
#pragma unroll
                for (int j = 0; j < 8; ++j) if (j != i0 && le[j] > m1) { m1 = le[j]; i1 = j; }
                const float e1 = __expf(m1 - m0), den = 1.f / (1.f + e1);
                if (lane == 0) {
                    int* sele = (int*)(a.ws + WS_SEL_E); float* selwv = (float*)(a.ws + WS_SEL_W);
                    sele[2 * n] = gi * 8 + i0; sele[2 * n + 1] = gi * 8 + i1;
                    selwv[2 * n] = gw_ * den; selwv[2 * n + 1] = gw_ * e1 * den;
                    __hip_atomic_fetch_add(hist + gi * 8 + i0, 1, __ATOMIC_RELAXED, __HIP_MEMORY_SCOPE_WORKGROUP); __hip_atomic_fetch_add(hist + gi * 8 + i1, 1, __ATOMIC_RELAXED, __HIP_MEMORY_SCOPE_WORKGROUP);
                }
            }
        }
        }
        if (MODE == 2) {
            __syncthreads();
            if (tid < 32) { ((int*)(a.ws + WS_CNT))[grp * 32 + tid] = hist[tid]; hist[tid] = 0; }
        }
    }
}

DEV void unpack8(const u32x4 w, float (&f)[8]) { f[0] = bf2f(w.x & 0xffffu); f[1] = bf2f(w.x >> 16); f[2] = bf2f(w.y & 0xffffu); f[3] = bf2f(w.y >> 16);
    f[4] = bf2f(w.z & 0xffffu); f[5] = bf2f(w.z >> 16); f[6] = bf2f(w.w & 0xffffu); f[7] = bf2f(w.w >> 16); }
DEV u32x4 pack8(const float (&f)[8]) { u32x4 w; w.x = pk2(f[0], f[1]); w.y = pk2(f[2], f[3]); w.z = pk2(f[4], f[5]); w.w = pk2(f[6], f[7]); return w; }
DEV void phase_mpre(KA& a, LAS unsigned char* lds, int l, const bool dum = false) {
    const int tid = opaque_tid(), G = gridDim.x, wg = blockIdx.x;
    {
        LAS float* gt = (LAS float*)lds;
        const float* lbv = (const float*)(a.ws + WS_LB) + l * 512;
        float* side = (float*)(a.ws + WS_HGSIDE);
        const int sub = tid >> 8, tg = (tid >> 6) & 3, dp = tid & 63, d = 2 * dp;
        for (int slot = wg; slot < NB * 64 * 2; slot += G) {
            const int item = slot * 2 + sub, b = item >> 8, c = (item >> 2) & 63, h = item & 3;
            bf16_t* zq = pool_blk(a, BK_HGQ + (h >> 1)) + (h & 1) * 128 + d;
            bf16_t* zf = pool_blk(a, BK_HGF + (h >> 1)) + (h & 1) * 128 + d;
            const size_t n0 = (size_t)b * T + c * 64 + tg * 16;
            const float lb0 = lbv[h * 128 + d], lb1 = lbv[h * 128 + d + 1];
            float qv[16][2], kv[16][2], pc[16][2]; float run0 = 0.f, run1 = 0.f;
#pragma unroll
            for (int i = 0; i < 16; ++i) { const unsigned wq = *(const unsigned*)(zq + (n0 + i) * 256), wf = *(const unsigned*)(zf + (n0 + i) * 256);
                const float f0 = lb0 + (1.f - lb0) * sigm(bf2f(wf & 0xffffu)), f1 = lb1 + (1.f - lb1) * sigm(bf2f(wf >> 16));
                qv[i][0] = silu(bf2f(wq & 0xffffu)) * 0.08838834764831845f; qv[i][1] = silu(bf2f(wq >> 16)) * 0.08838834764831845f;
                kv[i][0] = 1.f - f0; kv[i][1] = 1.f - f1;
                run0 += __logf(fmaxf(f0, 1e-30f)); run1 += __logf(fmaxf(f1, 1e-30f)); pc[i][0] = run0; pc[i][1] = run1; }
            __syncthreads();
            *(LAS f32x2*)(gt + (sub * 4 + tg) * 128 + d) = (f32x2){run0, run1};
            __syncthreads();
            const f32x2 g0 = *(const LAS f32x2*)(gt + (sub * 4 + 0) * 128 + d), g1 = *(const LAS f32x2*)(gt + (sub * 4 + 1) * 128 + d), g2_ = *(const LAS f32x2*)(gt + (sub * 4 + 2) * 128 + d), g3 = *(const LAS f32x2*)(gt + (sub * 4 + 3) * 128 + d);
            const f32x2 ref = g0 + g1, tot = ref + g2_ + g3;
            const f32x2 off = tg == 0 ? (f32x2){0.f, 0.f} : (tg == 1 ? g0 : (tg == 2 ? ref : ref + g2_));
#pragma unroll
            for (int i = 0; i < 16; ++i) { const float c0_ = off[0] + pc[i][0], c1_ = off[1] + pc[i][1];
                *(unsigned*)((dum ? zq + 28 * BLK_E : zq) + (n0 + i) * 256) = pk2(qv[i][0] * __expf(c0_ - ref[0]), qv[i][1] * __expf(c1_ - ref[1]));
                *(unsigned*)((dum ? zf + 28 * BLK_E : zf) + (n0 + i) * 256) = pk2(kv[i][0] * __expf(ref[0] - c0_), kv[i][1] * __expf(ref[1] - c1_)); }
            if (tg == 0) { float* sp = side + ((size_t)(b * 64 + c) * 4 + h) * 384 + d;
                *(f32x2*)sp = (f32x2){__expf(ref[0]), __expf(ref[1])}; *(f32x2*)(sp + 128) = (f32x2){__expf(tot[0]), __expf(tot[1])}; *(f32x2*)(sp + 256) = (f32x2){__expf(tot[0] - ref[0]), __expf(tot[1] - ref[1])}; }
        }
    }
    const int* pos = (const int*)a.in[I_POS];
    {
        const int p0 = wg * 512 + tid, h = (p0 >> 3) & 3, g = p0 & 7;
        float invf[8];
#pragma unroll
        for (int j = 0; j < 8; ++j) invf[j] = exp2f(-(float)(2 * (g * 8 + j)) * (13.287712379549449f / 128.f)) * 0.15915494309189535f;
        const int stride = G * 512;
        for (int pb = p0; pb < NTOK * 32; pb += 4 * stride) {
            u32x4 rq1[4], rq2[4], rk1[4], rk2[4]; float fp[4];
#pragma unroll
            for (int u = 0; u < 4; ++u) { const int p = pb + u * stride; if (p < NTOK * 32) { const int n = p >> 5;
                const size_t off = (size_t)n * 256 + (h & 1) * 128 + g * 8;
                const bf16_t* q = pool_blk(a, BK_RTQ + (h >> 1)) + off; const bf16_t* k = pool_blk(a, BK_RTK + (h >> 1)) + off;
                fp[u] = (float)pos[n]; rq1[u] = *(const u32x4*)q; rq2[u] = *(const u32x4*)(q + 64); rk1[u] = *(const u32x4*)k; rk2[u] = *(const u32x4*)(k + 64); } }
#pragma unroll
            for (int u = 0; u < 4; ++u) { const int p = pb + u * stride; if (p < NTOK * 32) { const int n = p >> 5;
                float sn[8], cs[8];
#pragma unroll
                for (int j = 0; j < 8; ++j) { float rev = fp[u] * invf[j]; rev -= floorf(rev); sn[j] = __builtin_amdgcn_sinf(rev); cs[j] = __builtin_amdgcn_cosf(rev); }
                const size_t off = (size_t)n * 256 + (h & 1) * 128 + g * 8;
                bf16_t* q = pool_blk(a, BK_RTQ + (h >> 1)) + off; bf16_t* k = pool_blk(a, BK_RTK + (h >> 1)) + off;
                float q1[8], q2[8], k1[8], k2[8], o1[8], o2[8];
                unpack8(rq1[u], q1); unpack8(rq2[u], q2); unpack8(rk1[u], k1); unpack8(rk2[u], k2);
                bf16_t* qo = dum ? q + 16 * BLK_E : q; bf16_t* ko = dum ? k + 16 * BLK_E : k;
                const float sc_ = 0.08838834764831845f;
#pragma unroll
                for (int j = 0; j < 8; ++j) { o1[j] = (q1[j] * cs[j] - q2[j] * sn[j]) * sc_; o2[j] = (q1[j] * sn[j] + q2[j] * cs[j]) * sc_; }
                *(u32x4*)qo = pack8(o1); *(u32x4*)(qo + 64) = pack8(o2);
#pragma unroll
                for (int j = 0; j < 8; ++j) { o1[j] = k1[j] * cs[j] - k2[j] * sn[j]; o2[j] = k1[j] * sn[j] + k2[j] * cs[j]; }
                *(u32x4*)ko = pack8(o1); *(u32x4*)(ko + 64) = pack8(o2); } }
        }
    }
    const bf16_t* zl = pool_blk(a, BK_RWL); bf16_t* ap = pool_blk(a, BK_LIN);
    const float* mu = FIN(I_MU) + (size_t)l * 1792 + 1536;
    {
        const int p0 = wg * 512 + tid, c0 = (p0 & 31) * 8, stride = G * 512;
        float muv[8];
#pragma unroll
        for (int j = 0; j < 8; ++j) muv[j] = mu[c0 + j];
        for (int pb = p0; pb < NTOK * 32; pb += 4 * stride) {
            u32x4 rr[4], rp[4];
#pragma unroll
            for (int u = 0; u < 4; ++u) { const int p = pb + u * stride; if (p < NTOK * 32) { const int n = p >> 5, t = n & (T - 1);
                rr[u] = *(const u32x4*)(zl + (size_t)n * 256 + c0); rp[u] = (t > 0) ? *(const u32x4*)(zl + (size_t)(n - 1) * 256 + c0) : (u32x4){0u, 0u, 0u, 0u}; } }
#pragma unroll
            for (int u = 0; u < 4; ++u) { const int p = pb + u * stride; if (p < NTOK * 32) { const int n = p >> 5;
                float raw[8], prev[8], o[8];
                unpack8(rr[u], raw); unpack8(rp[u], prev);
#pragma unroll
                for (int j = 0; j < 8; ++j) { const float zs = raw[j] + muv[j] * (prev[j] - raw[j]);
                    o[j] = c0 < 64 ? tanhf(zs) : (c0 < 128 ? zs : sigm(zs)); }
                *(u32x4*)(ap + (size_t)n * 256 + c0) = pack8(o); } }
        }
    }
}


DEV void phase_scan_chunk(KA& a, LAS unsigned char* lds, int l, const bool dum = false) {
    const int tid = opaque_tid(), lane = tid & 63, wave = tid >> 6, G = gridDim.x, wg = blockIdx.x;
    constexpr int SQ = 272, SK = 144;
    constexpr int O_QE = 0, O_KE = 17408, O_KT = 34816, O_VT = 53248, BUFSZ = 57856;
    constexpr int O_ST = 2 * BUFSZ, STSZ = 8704, O_P = O_ST + 2 * STSZ, PSZ = 9216;
    static_assert(O_P + PSZ <= LDS_MISC, "LDS map");
    const int fr = lane & 15, fq = lane >> 4;
    const int ti = wave >> 1, vi = wave & 1;
    const float* side = (const float*)(a.ws + WS_HGSIDE);
    for (int it0 = wg; it0 < 256; it0 += G) {
        const int item = (G == 256) ? (((it0 & 7) * 8 + (it0 >> 5)) * 4 + ((it0 >> 3) & 3)) : it0;
        const int type = item >> 7, b = (item >> 4) & 7, h = (item >> 2) & 3, j = item & 3;
        const bf16_t* gq = pool_blk(a, (type ? BK_RTQ : BK_HGQ) + (h >> 1)) + (h & 1) * 128;
        const bf16_t* gk = pool_blk(a, (type ? BK_RTK : BK_HGF) + (h >> 1)) + (h & 1) * 128;
        bf16_t* gv = pool_blk(a, (type ? BK_RTV : BK_HGI) + (h >> 1)) + (h & 1) * 128 + j * 32;
        bf16_t* go = dum ? pool_blk(a, 30 + (h >> 1)) + (h & 1) * 128 + j * 32 : gv;
        const float lg2g = log2f(1.f - exp2f(-5.f - (float)h));
        const float g64 = exp2f(64.f * lg2g);
        __syncthreads();
        for (int i = tid; i < (2 * STSZ + PSZ) / 4; i += 512) ((LAS unsigned*)(lds + O_ST))[i] = 0u;
        u32x4 rqA[2], rkA[2], rvA[2], rqB[2], rkB[2], rvB[2];
        f32x4 S0 = (f32x4){0.f, 0.f, 0.f, 0.f}, S1 = S0;
        const int rp = tid >> 4, ch = tid & 15, rpv = (tid >> 2) & 31, chv = tid & 3;
        const float zs0 = type ? exp2f((float)(63 - 2 * rp) * lg2g) : 1.f, zs1 = type ? exp2f((float)(62 - 2 * rp) * lg2g) : 1.f;
        float mk[2][4], rsc[4];
#pragma unroll
        for (int q = 0; q < 2; ++q)
#pragma unroll
            for (int r = 0; r < 4; ++r) { const int t = 16 * ti + 4 * fq + r, s_ = 16 * (2 * (wave & 1) + q) + fr; mk[q][r] = (t >= s_) ? (type ? exp2f((float)(t - s_) * lg2g) : 1.f) : 0.f; }
#pragma unroll
        for (int r = 0; r < 4; ++r) rsc[r] = type ? exp2f((float)(16 * ti + 4 * fq + r + 1) * lg2g) : 1.f;
#define SC_LOAD(RQ, RK_, RV, cc) do { const size_t n0_ = (size_t)b * T + (size_t)(cc) * 64; \
            _Pragma("unroll") for (int i = 0; i < 2; ++i) { RQ[i] = *(const u32x4*)(gq + (n0_ + 2 * rp + i) * 256 + ch * 8); RK_[i] = *(const u32x4*)(gk + (n0_ + 2 * rp + i) * 256 + ch * 8); } \
            if (tid < 128) { _Pragma("unroll") for (int i = 0; i < 2; ++i) RV[i] = *(const u32x4*)(gv + (n0_ + 2 * rpv + i) * 256 + chv * 8); } } while (0)
#define SC_WRITE(RQ, RK_, RV, pb) do { LAS unsigned char* B_ = lds + (pb) * BUFSZ; \
            _Pragma("unroll") for (int i = 0; i < 2; ++i) { *(LAS u32x4*)(B_ + O_QE + (2 * rp + i) * SQ + ch * 16) = RQ[i]; *(LAS u32x4*)(B_ + O_KE + (2 * rp + i) * SQ + ch * 16) = RK_[i]; } \
            { float k0[8], k1[8]; unpack8(RK_[0], k0); unpack8(RK_[1], k1); \
              _Pragma("unroll") for (int e = 0; e < 8; ++e) *(LAS unsigned*)(B_ + O_KT + (ch * 8 + e) * SK + (((rp >> 2) ^ (ch & 7)) * 16) + (rp & 3) * 4) = pk2(k0[e] * zs0, k1[e] * zs1); } \
            if (tid < 128) { const unsigned w0_[4] = {RV[0].x, RV[0].y, RV[0].z, RV[0].w}, w1_[4] = {RV[1].x, RV[1].y, RV[1].z, RV[1].w}; \
                _Pragma("unroll") for (int e = 0; e < 8; ++e) { const unsigned lo_ = (w0_[e >> 1] >> ((e & 1) * 16)) & 0xffffu, hi_ = (w1_[e >> 1] >> ((e & 1) * 16)) & 0xffffu; \
                    *(LAS unsigned*)(B_ + O_VT + (chv * 8 + e) * SK + (((rpv >> 2) ^ chv) * 16) + (rpv & 3) * 4) = lo_ | (hi_ << 16); } } } while (0)
#define SC_KT(row, kc) (O_KT + (row) * SK + ((((kc)) ^ (((row) >> 3) & 7)) * 16))
#define SC_VT(row, kc) (O_VT + (row) * SK + ((((kc)) ^ (((row) >> 3) & 3)) * 16))
#define SC_SIDE(A_, B_, E_, cc) do { _Pragma("unroll") for (int q = 0; q < 2; ++q) { const int d = 16 * (2 * (wave >> 1) + q) + fr; \
            if (type == 0 && (cc) < 64) { const float* sp = side + ((size_t)(b * 64 + (cc)) * 4 + h) * 384 + d; A_[q] = sp[128]; B_[q] = sp[256]; E_[q] = ((cc) + 1 < 64) ? sp[4 * 384] : 1.f; } \
            else { A_[q] = g64; B_[q] = 1.f; E_[q] = 1.f; } } } while (0)
#define SC_BODY(c, pb, LQ, LK, LV, WQ, WK, WV) do { \
            LAS unsigned char* B = lds + (pb) * BUFSZ; \
            const size_t n0 = (size_t)b * T + (size_t)(c) * 64; \
            SC_SIDE(na, nb, ne, (c) + 1);     \
            if ((c) + 2 < 64) SC_LOAD(LQ, LK, LV, (c) + 2); \
            _Pragma("unroll") for (int q = 0; q < 2; ++q) { const int si = 2 * (wave & 1) + q; \
                if (si <= ti) { \
                    f32x4 acc = (f32x4){0.f, 0.f, 0.f, 0.f}; \
                    _Pragma("unroll") for (int kk = 0; kk < 4; ++kk) { const bf16x8 af = *(const LAS bf16x8*)(B + O_QE + (16 * ti + fr) * SQ + (32 * kk + 8 * fq) * 2); \
                        const bf16x8 bf = *(const LAS bf16x8*)(B + O_KE + (16 * si + fr) * SQ + (32 * kk + 8 * fq) * 2); \
                        acc = __builtin_amdgcn_mfma_f32_16x16x32_bf16(af, bf, acc, 0, 0, 0); } \
                    _Pragma("unroll") for (int r = 0; r < 4; ++r) { const int t = 16 * ti + 4 * fq + r, s_ = 16 * si + fr; \
                        *(LAS bf16_t*)(lds + O_P + t * SK + s_ * 2) = (bf16_t)f2bf(acc[r] * mk[q][r]); } \
                } } \
            LDS_BARRIER(); \
            { \
                f32x4 acc = (f32x4){0.f, 0.f, 0.f, 0.f}; \
                _Pragma("unroll") for (int kk = 0; kk < 4; ++kk) { const bf16x8 af = *(const LAS bf16x8*)(B + O_QE + (16 * ti + fr) * SQ + (32 * kk + 8 * fq) * 2); \
                    const bf16x8 bf = *(const LAS bf16x8*)(lds + O_ST + (pb) * STSZ + (16 * vi + fr) * SQ + (32 * kk + 8 * fq) * 2); \
                    acc = __builtin_amdgcn_mfma_f32_16x16x32_bf16(af, bf, acc, 0, 0, 0); } \
                _Pragma("unroll") for (int r = 0; r < 4; ++r) acc[r] *= rsc[r]; \
                _Pragma("unroll") for (int kk = 0; kk < 2; ++kk) if (kk == 0 || ti >= 2) { const bf16x8 af = *(const LAS bf16x8*)(lds + O_P + (16 * ti + fr) * SK + (32 * kk + 8 * fq) * 2); \
                    const bf16x8 bf = *(const LAS bf16x8*)(B + SC_VT(16 * vi + fr, 4 * kk + fq)); \
                    acc = __builtin_amdgcn_mfma_f32_16x16x32_bf16(af, bf, acc, 0, 0, 0); } \
                _Pragma("unroll") for (int r = 0; r < 4; ++r) go[(n0 + 16 * ti + 4 * fq + r) * 256 + 16 * vi + fr] = (bf16_t)f2bf(acc[r]); \
            } \
            _Pragma("unroll") for (int q = 0; q < 2; ++q) { const int di = 2 * (wave >> 1) + q; \
                f32x4 acc = (f32x4){0.f, 0.f, 0.f, 0.f}; \
                _Pragma("unroll") for (int kk = 0; kk < 2; ++kk) { const bf16x8 af = *(const LAS bf16x8*)(B + SC_VT(16 * vi + fr, 4 * kk + fq)); \
                    const bf16x8 bf = *(const LAS bf16x8*)(B + SC_KT(16 * di + fr, 4 * kk + fq)); \
                    acc = __builtin_amdgcn_mfma_f32_16x16x32_bf16(af, bf, acc, 0, 0, 0); } \
                f32x4 Sn = (q == 0 ? S0 : S1) * sa[q] + acc * sb[q]; \
                if (q == 0) S0 = Sn; else S1 = Sn; \
                _Pragma("unroll") for (int r = 0; r < 4; ++r) *(LAS bf16_t*)(lds + O_ST + ((pb) ^ 1) * STSZ + (16 * vi + 4 * fq + r) * SQ + (16 * di + fr) * 2) = (bf16_t)f2bf(Sn[r] * se[q]); \
            } \
            if ((c) + 1 < 64) SC_WRITE(WQ, WK, WV, (pb) ^ 1); \
            _Pragma("unroll") for (int q = 0; q < 2; ++q) { sa[q] = na[q]; sb[q] = nb[q]; se[q] = ne[q]; } \
            LDS_BARRIER(); } while (0)
        float sa[2], sb[2], se[2], na[2], nb[2], ne[2];
        SC_SIDE(sa, sb, se, 0);
        SC_LOAD(rqA, rkA, rvA, 0);
        SC_WRITE(rqA, rkA, rvA, 0);
        SC_LOAD(rqA, rkA, rvA, 1);
        LDS_BARRIER();
        for (int c = 0; c < 64; c += 2) {
            SC_BODY(c, 0, rqB, rkB, rvB, rqA, rkA, rvA);
            SC_BODY(c + 1, 1, rqA, rkA, rvA, rqB, rkB, rvB);
        }
#undef SC_BODY
#undef SC_SIDE
#undef SC_KT
#undef SC_VT
#undef SC_LOAD
#undef SC_WRITE
    }
}

#define DPPF(x, ctrl, rmask) __builtin_bit_cast(float, __builtin_amdgcn_update_dpp(0, __builtin_bit_cast(int, x), ctrl, rmask, 0xF, true))
DEV float row16_sum_f(float x) { x += DPPF(x, 0xB1, 0xF); x += DPPF(x, 0x4E, 0xF); x += DPPF(x, 0x141, 0xF); x += DPPF(x, 0x140, 0xF); return x; }
DEV float wave_sum_dpp(float x) {
    x = row16_sum_f(x);
    x += __builtin_bit_cast(float, __builtin_amdgcn_update_dpp(0, __builtin_bit_cast(int, x), 0x142, 0xA, 0xF, false));
    x += __builtin_bit_cast(float, __builtin_amdgcn_update_dpp(0, __builtin_bit_cast(int, x), 0x143, 0xC, 0xF, false));
    return __builtin_bit_cast(float, __builtin_amdgcn_readlane(__builtin_bit_cast(int, x), 63));
}
typedef unsigned short u16x4 __attribute__((ext_vector_type(4)));
constexpr int CW_S = 144;
constexpr int CW_IMG = 64 * CW_S;
DEV unsigned lds_addr(const LAS unsigned char* p) { return (unsigned)(size_t)p; }
DEV bf16x8 cw_rowfrag(const LAS unsigned char* img, int rt, int kk, int fr, int fq) { return *(const LAS bf16x8*)(img + (16 * rt + fr) * CW_S + (32 * kk + 8 * fq) * 2); }
DEV void cw_trfrag2(const LAS unsigned char* img, int ct, int lane, bf16x8 (&f)[2]) {
    const int fq = lane >> 4, q = (lane & 15) >> 2, p = lane & 3;
    const unsigned a0 = lds_addr(img) + (8 * fq + q) * CW_S + (16 * ct + 4 * p) * 2;
    u16x4 r0, r1, r2, r3;
    asm volatile("ds_read_b64_tr_b16 %0, %4\n\tds_read_b64_tr_b16 %1, %4 offset:576\n\tds_read_b64_tr_b16 %2, %4 offset:4608\n\tds_read_b64_tr_b16 %3, %4 offset:5184\n\ts_waitcnt lgkmcnt(0)"
                 : "=&v"(r0), "=&v"(r1), "=&v"(r2), "=&v"(r3) : "v"(a0) : "memory");
    f[0] = (bf16x8){(short)r0[0], (short)r0[1], (short)r0[2], (short)r0[3], (short)r1[0], (short)r1[1], (short)r1[2], (short)r1[3]};
    f[1] = (bf16x8){(short)r2[0], (short)r2[1], (short)r2[2], (short)r2[3], (short)r3[0], (short)r3[1], (short)r3[2], (short)r3[3]};
}
template <bool ATR, bool BTR> DEV void cw_mm(const LAS unsigned char* Aimg, const LAS unsigned char* Bimg, int mt, int nt0, int lane, f32x4 (&acc)[2]) {
    const int fr = lane & 15, fq = lane >> 4;
    bf16x8 af[2], bf0[2], bf1[2];
    if (ATR) cw_trfrag2(Aimg, mt, lane, af); else { af[0] = cw_rowfrag(Aimg, mt, 0, fr, fq); af[1] = cw_rowfrag(Aimg, mt, 1, fr, fq); }
    if (BTR) { cw_trfrag2(Bimg, nt0, lane, bf0); cw_trfrag2(Bimg, nt0 + 1, lane, bf1); }
    else { bf0[0] = cw_rowfrag(Bimg, nt0, 0, fr, fq); bf0[1] = cw_rowfrag(Bimg, nt0, 1, fr, fq); bf1[0] = cw_rowfrag(Bimg, nt0 + 1, 0, fr, fq); bf1[1] = cw_rowfrag(Bimg, nt0 + 1, 1, fr, fq); }
    asm volatile("s_waitcnt lgkmcnt(0)" ::: "memory"); __builtin_amdgcn_sched_barrier(0);
#pragma unroll
    for (int kk = 0; kk < 2; ++kk) { acc[0] = __builtin_amdgcn_mfma_f32_16x16x32_bf16(af[kk], bf0[kk], acc[0], 0, 0, 0); acc[1] = __builtin_amdgcn_mfma_f32_16x16x32_bf16(af[kk], bf1[kk], acc[1], 0, 0, 0); }
}
DEV void cw_put(LAS unsigned char* img, int mt, int nt, int lane, const f32x4 v) {
    const int fr = lane & 15, fq = lane >> 4;
    u32x2 w; w.x = pk2(v[0], v[1]); w.y = pk2(v[2], v[3]);
    *(LAS u32x2*)(img + (16 * nt + fr) * CW_S + (16 * mt + 4 * fq) * 2) = w;
}
DEV void cw_trfrag4(const LAS unsigned char* imgA, int ctA, const LAS unsigned char* imgB, int ctB, int lane, bf16x8 (&fa)[2], bf16x8 (&fb)[2]) {
    const int fq = lane >> 4, q = (lane & 15) >> 2, p = lane & 3;
    const unsigned a0 = lds_addr(imgA) + (8 * fq + q) * CW_S + (16 * ctA + 4 * p) * 2, b0 = lds_addr(imgB) + (8 * fq + q) * CW_S + (16 * ctB + 4 * p) * 2;
    u16x4 r0, r1, r2, r3, r4, r5, r6, r7;
    asm volatile("ds_read_b64_tr_b16 %0, %8\n\tds_read_b64_tr_b16 %1, %8 offset:576\n\tds_read_b64_tr_b16 %2, %8 offset:4608\n\tds_read_b64_tr_b16 %3, %8 offset:5184\n\t"
                 "ds_read_b64_tr_b16 %4, %9\n\tds_read_b64_tr_b16 %5, %9 offset:576\n\tds_read_b64_tr_b16 %6, %9 offset:4608\n\tds_read_b64_tr_b16 %7, %9 offset:5184\n\ts_waitcnt lgkmcnt(0)"
                 : "=&v"(r0), "=&v"(r1), "=&v"(r2), "=&v"(r3), "=&v"(r4), "=&v"(r5), "=&v"(r6), "=&v"(r7) : "v"(a0), "v"(b0) : "memory");
    fa[0] = (bf16x8){(short)r0[0], (short)r0[1], (short)r0[2], (short)r0[3], (short)r1[0], (short)r1[1], (short)r1[2], (short)r1[3]};
    fa[1] = (bf16x8){(short)r2[0], (short)r2[1], (short)r2[2], (short)r2[3], (short)r3[0], (short)r3[1], (short)r3[2], (short)r3[3]};
    fb[0] = (bf16x8){(short)r4[0], (short)r4[1], (short)r4[2], (short)r4[3], (short)r5[0], (short)r5[1], (short)r5[2], (short)r5[3]};
    fb[1] = (bf16x8){(short)r6[0], (short)r6[1], (short)r6[2], (short)r6[3], (short)r7[0], (short)r7[1], (short)r7[2], (short)r7[3]};
}
#define CW_MMA(ACC, AF, B0, B1) do { _Pragma("unroll") for (int kk_ = 0; kk_ < 2; ++kk_) { \
        ACC[0] = __builtin_amdgcn_mfma_f32_16x16x32_bf16(AF[kk_], B0[kk_], ACC[0], 0, 0, 0); ACC[1] = __builtin_amdgcn_mfma_f32_16x16x32_bf16(AF[kk_], B1[kk_], ACC[1], 0, 0, 0); } } while (0)
#define CW_ZERO(X) X[0] = X[1] = (f32x4){0.f, 0.f, 0.f, 0.f}
#define CW_FENCE() do { asm volatile("s_waitcnt lgkmcnt(0)" ::: "memory"); __builtin_amdgcn_sched_barrier(0); } while (0)
constexpr size_t PO_CWPQ = 0;
constexpr size_t PO_CWRO = 8 * BLK_B;
typedef short bf16x4 __attribute__((ext_vector_type(4)));
DEV bf16x4 cvt4(const f32x4 v) { u32x2 w; w.x = pk2(v[0], v[1]); w.y = pk2(v[2], v[3]); return __builtin_bit_cast(bf16x4, w); }
DEV bf16x8 cat8(const bf16x4 a, const bf16x4 b) { return __builtin_shufflevector(a, b, 0, 1, 2, 3, 4, 5, 6, 7); }
DEV bf16x4 lo4(const bf16x8 v) { return __builtin_shufflevector(v, v, 0, 1, 2, 3); }
DEV bf16x4 hi4(const bf16x8 v) { return __builtin_shufflevector(v, v, 4, 5, 6, 7); }
DEV f32x4 up4(const bf16x4 v) { const u32x2 w = __builtin_bit_cast(u32x2, v); return (f32x4){bf2f(w.x & 0xffffu), __uint_as_float(w.x & 0xffff0000u), bf2f(w.y & 0xffffu), __uint_as_float(w.y & 0xffff0000u)}; }
#define MF16(A, B, C) __builtin_amdgcn_mfma_f32_16x16x16bf16_1k(A, B, C, 0, 0, 0)
#define MF32(A, B, C) __builtin_amdgcn_mfma_f32_16x16x32_bf16(A, B, C, 0, 0, 0)
constexpr int CW_AT = 0, CW_RT = 1, CW_BH = 2, CW_KH = 3;
constexpr int CWF = 4 * CW_IMG;
constexpr int CWF_AT = CWF, CWF_BH = CWF + 8192, CWF_KH = CWF + 16384, CWF_V = CWF + 24576;
constexpr int CWM = CWF + 4 * 8192;
constexpr int CWM_AB = CWM, CWM_AK = CWM + 8192, CWM_RB = CWM + 16384, CWM_RK = CWM + 24576;
constexpr int CWT = CWM + 4 * 8192;
constexpr int CW_SIDE = CWT + 2048;
static_assert(CW_SIDE + (8 * 64 + 3 * 64) * 4 <= LDS_MISC, "RW1 LDS map");
DEV void phase_rw1(KA& a, LAS unsigned char* lds, int l) {
    const int tid = opaque_tid(), lane = tid & 63, wave = tid >> 6, G = gridDim.x, wg = blockIdx.x;
    const int fr = lane & 15, fq = lane >> 4, mt = wave >> 1, nt0 = 2 * (wave & 1);
    float* RK = (float*)(a.ws + WS_RK);
    LAS float* side = (LAS float*)(lds + CW_SIDE);
#define IMG(i) (lds + (i) * CW_IMG)
    unsigned gr[8], gk[8], gv[8], glw[8], gla[8], gpr = 0, gpk = 0, gpv = 0;
    float pmur = 0.f, pmuk = 0.f, pmuv = 0.f, pw0 = 0.f, pa0 = 0.f, pkkp = 0.f, pkap = 0.f, prkp = 0.f;
#define RW1_LOAD(ci_) do { const int c_ = (ci_) & 63, h_ = ((ci_) >> 6) & 7, b_ = (ci_) >> 9, hb_ = h_ >> 2, cb_ = (h_ & 3) * 64 + (lane & ~1); \
        const size_t n_ = (size_t)b_ * T + c_ * 64 + wave * 8; \
        const unsigned* zr_ = (const unsigned*)(pool_blk(a, BK_RWR + hb_) + cb_); const unsigned* zk_ = (const unsigned*)(pool_blk(a, BK_RWK + hb_) + cb_); const unsigned* zv_ = (const unsigned*)(pool_blk(a, BK_RWV + hb_) + cb_); \
        const unsigned* lwp_ = (const unsigned*)(pool_blk(a, BK_LW + hb_) + cb_); const unsigned* lap_ = (const unsigned*)(pool_blk(a, BK_LA + hb_) + cb_); \
        _Pragma("unroll") for (int q = 0; q < 8; ++q) { gr[q] = zr_[(n_ + q) * 128]; gk[q] = zk_[(n_ + q) * 128]; gv[q] = zv_[(n_ + q) * 128]; glw[q] = lwp_[(n_ + q) * 128]; gla[q] = lap_[(n_ + q) * 128]; } \
        if ((n_ & (T - 1)) > 0) { gpr = zr_[(n_ - 1) * 128]; gpk = zk_[(n_ - 1) * 128]; gpv = zv_[(n_ - 1) * 128]; } else { gpr = 0; gpk = 0; gpv = 0; } \
        { const int ch_ = h_ * 64 + lane; pmur = FIN(I_MU)[l * 1792 + ch_]; pmuk = FIN(I_MU)[l * 1792 + 512 + ch_]; pmuv = FIN(I_MU)[l * 1792 + 1024 + ch_]; \
          pw0 = FIN(I_W0)[l * 512 + ch_]; pa0 = FIN(I_A0)[l * 512 + ch_]; pkkp = FIN(I_KK)[l * 512 + ch_]; pkap = FIN(I_KA)[l * 512 + ch_]; prkp = FIN(I_RK)[l * 512 + ch_]; } } while (0)
    const unsigned gsel = (lane & 1) ? 0x07060c0cu : 0x05040c0cu;
#define BFS(w) __uint_as_float(__builtin_amdgcn_perm((w), 0u, gsel))
    for (int i = tid; i < (4 * 8192 + 2048) / 4; i += 512) ((LAS unsigned*)(lds + CWM))[i] = 0u;
    if (wg < NB * 8 * 64) RW1_LOAD(wg);
    for (int ci = wg; ci < NB * 8 * 64; ci += G) {
        const int h = (ci >> 6) & 7, b = ci >> 9, c = ci & 63;
        const size_t n0 = (size_t)b * T + c * 64 + wave * 8;
        const float mur = pmur, muk = pmuk, muv = pmuv, w0 = pw0, a0 = pa0, kkp = pkkp, kap = pkap, rkp = prkp;
        float rs[8], ks[8], vs[8], lx[8], av[8], nk[8], sq[8], rkx[8];
        {
            float rp = BFS(gpr), kp_ = BFS(gpk), vp = BFS(gpv);
#pragma unroll
            for (int q = 0; q < 8; ++q) {
                const float r0 = BFS(gr[q]), k0 = BFS(gk[q]), v0 = BFS(gv[q]);
                rs[q] = r0 + mur * (rp - r0); ks[q] = k0 + muk * (kp_ - k0); vs[q] = v0 + muv * (vp - v0); rp = r0; kp_ = k0; vp = v0;
                lx[q] = -0.8750340975f * sigm(w0 + BFS(glw[q]));
                av[q] = sigm(a0 + BFS(gla[q]));
                nk[q] = ks[q] * kkp; sq[q] = nk[q] * nk[q];
                ks[q] = ks[q] * (1.f + (av[q] - 1.f) * kap);
                rkx[q] = rs[q] * ks[q] * rkp;
            }
        }
        __builtin_amdgcn_sched_barrier(0);
        { const int cn_ = (ci + G < NB * 8 * 64) ? ci + G : ci; RW1_LOAD(cn_); }
        {
            const bool b0 = (lane & 1) != 0, b1 = (lane & 2) != 0, b2 = (lane & 4) != 0, b3 = (lane & 8) != 0;
            float u[8], w4[4], z2[2];
#pragma unroll
            for (int i = 0; i < 8; ++i) { const float a_ = (i < 4) ? sq[2 * i] : rkx[2 * i - 8], b_ = (i < 4) ? sq[2 * i + 1] : rkx[2 * i - 7]; u[i] = (b0 ? b_ : a_) + DPPF(b0 ? a_ : b_, 0xB1, 0xF); }
#pragma unroll
            for (int i = 0; i < 4; ++i) w4[i] = (b1 ? u[2 * i + 1] : u[2 * i]) + DPPF(b1 ? u[2 * i] : u[2 * i + 1], 0x4E, 0xF);
#pragma unroll
            for (int i = 0; i < 2; ++i) z2[i] = (b2 ? w4[2 * i + 1] : w4[2 * i]) + DPPF(b2 ? w4[2 * i] : w4[2 * i + 1], 0x124, 0xF);
            float y = (b3 ? z2[1] : z2[0]) + DPPF(b3 ? z2[0] : z2[1], 0x128, 0xF);
            y += __builtin_bit_cast(float, __builtin_amdgcn_ds_bpermute((lane ^ 32) * 4, __builtin_bit_cast(int, y)));
            y += __builtin_bit_cast(float, __builtin_amdgcn_ds_bpermute((lane ^ 16) * 4, __builtin_bit_cast(int, y)));
#pragma unroll
            for (int q = 0; q < 8; ++q) { sq[q] = __builtin_bit_cast(float, __builtin_amdgcn_readlane(__builtin_bit_cast(int, y), q)); rkx[q] = __builtin_bit_cast(float, __builtin_amdgcn_readlane(__builtin_bit_cast(int, y), 8 + q)); }
        }
        float cl[8];
        { float run = 0.f;
#pragma unroll
          for (int q = 0; q < 8; ++q) { nk[q] = -nk[q] * __builtin_amdgcn_rsqf(fmaxf(sq[q], 1e-24f)); run += lx[q]; cl[q] = run; }
          if (lane == 0) {
#pragma unroll
              for (int q = 0; q < 8; ++q) RK[(n0 + q) * 8 + h] = rkx[q]; }
          side[wave * 64 + lane] = run; }
        LDS_BARRIER();
        float off = 0.f, ref = 0.f, tot = 0.f;
#pragma unroll
        for (int w2 = 0; w2 < 8; ++w2) { const float tv = side[w2 * 64 + lane]; if (w2 < wave) off += tv; if (w2 < 4) ref += tv; tot += tv; }
        const float eref = __builtin_amdgcn_exp2f(ref);
        if (wave == 0) { side[512 + lane] = eref; side[576 + lane] = __builtin_amdgcn_exp2f(tot); side[640 + lane] = __builtin_amdgcn_exp2f(tot - ref); }
        {
            float fa[8], fb[8], fk[8];
            float eprev = __builtin_amdgcn_exp2f(off - ref);
#pragma unroll
            for (int q = 0; q < 8; ++q) {
                const int t = wave * 8 + q; const float ci_ = off + cl[q];
                const float eu = __builtin_amdgcn_exp2f(ci_ - ref), ed = __builtin_amdgcn_exp2f(ref - ci_), ep = eprev; eprev = eu;
                const float at = nk[q] * ep, rt = rs[q] * eu; fb[q] = -nk[q] * av[q] * ed; fk[q] = ks[q] * ed; fa[q] = at * eref;
                *(LAS bf16_t*)(IMG(CW_AT) + t * CW_S + lane * 2) = (bf16_t)f2bf(at);
                *(LAS bf16_t*)(IMG(CW_RT) + t * CW_S + lane * 2) = (bf16_t)f2bf(rt);
                *(LAS bf16_t*)(IMG(CW_BH) + t * CW_S + lane * 2) = (bf16_t)f2bf(fb[q]);
                *(LAS bf16_t*)(IMG(CW_KH) + t * CW_S + lane * 2) = (bf16_t)f2bf(fk[q]);
            }
#pragma unroll
            for (int qh = 0; qh < 2; ++qh) {
                const int so = (((lane >> 4) * 2 + (wave >> 2)) * 64 + (2 * (wave & 1) + qh) * 16 + (lane & 15)) * 16 + ((wave >> 1) & 1) * 8;
                u32x2 w;
                w.x = pk2(fa[4 * qh], fa[4 * qh + 1]); w.y = pk2(fa[4 * qh + 2], fa[4 * qh + 3]); *(LAS u32x2*)(lds + CWF_AT + so) = w;
                w.x = pk2(fb[4 * qh], fb[4 * qh + 1]); w.y = pk2(fb[4 * qh + 2], fb[4 * qh + 3]); *(LAS u32x2*)(lds + CWF_BH + so) = w;
                w.x = pk2(fk[4 * qh], fk[4 * qh + 1]); w.y = pk2(fk[4 * qh + 2], fk[4 * qh + 3]); *(LAS u32x2*)(lds + CWF_KH + so) = w;
                w.x = pk2(vs[4 * qh], vs[4 * qh + 1]); w.y = pk2(vs[4 * qh + 2], vs[4 * qh + 3]); *(LAS u32x2*)(lds + CWF_V + so) = w;
            }
        }
        LDS_BARRIER();
#define LD2(F, img, blk) do { F[0] = cw_rowfrag(IMG(img), (blk), 0, fr, fq); F[1] = cw_rowfrag(IMG(img), (blk), 1, fr, fq); } while (0)
#define MM2(XA, YB) MF32(XA[1], YB[1], MF32(XA[0], YB[0], Z0))
#define PUTM(base, i, j, C) (*(LAS bf16x4*)(lds + (base) + (((i) * 2 + ((j) >> 1)) * 64 + lane) * 16 + ((j) & 1) * 8) = cvt4(C))
        const f32x4 Z0 = {0.f, 0.f, 0.f, 0.f};
        if (wave < 4) {
            const int i = wave;
            bf16x8 ya[2], xb[2]; LD2(ya, CW_AT, i); LD2(xb, CW_BH, i);
            f32x4 X = MM2(ya, xb), Xt = MM2(xb, ya), St;
#pragma unroll
            for (int r = 0; r < 4; ++r) { X[r] = (4 * fq + r > fr) ? X[r] : 0.f; Xt[r] = (fr > 4 * fq + r) ? Xt[r] : 0.f; St[r] = Xt[r] + ((4 * fq + r == fr) ? 1.f : 0.f); }
            const bf16x4 c0 = cvt4(X), c0t = cvt4(Xt);
            const f32x4 P1 = MF16(c0t, c0, Z0), P1t = MF16(c0, c0t, Z0);
            const bf16x4 c1 = cvt4(P1), c1t = cvt4(P1t);
            St = MF16(c1, cvt4(St), St);
            const f32x4 P2 = MF16(c1t, c1, Z0), P2t = MF16(c1, c1t, Z0);
            const bf16x4 c2 = cvt4(P2), c2t = cvt4(P2t);
            St = MF16(c2, cvt4(St), St);
            const f32x4 P3 = MF16(c2t, c2, Z0);
            St = MF16(cvt4(P3), cvt4(St), St);
            *(LAS bf16x4*)(lds + CWT + (i * 64 + lane) * 8) = cvt4(St);
        } else {
            const int u = wave - 4;
            {
                bf16x8 xb[2], xk[2], ya[2], yr[2]; LD2(xb, CW_BH, u); LD2(xk, CW_KH, u); LD2(ya, CW_AT, u); LD2(yr, CW_RT, u);
                f32x4 ak = MM2(xk, ya), rb = MM2(xb, yr), rk = MM2(xk, yr);
#pragma unroll
                for (int r = 0; r < 4; ++r) { ak[r] = (fr > 4 * fq + r) ? ak[r] : 0.f; rb[r] = (fr >= 4 * fq + r) ? rb[r] : 0.f; rk[r] = (fr >= 4 * fq + r) ? rk[r] : 0.f; }
                PUTM(CWM_AK, u, u, ak); PUTM(CWM_RB, u, u, rb); PUTM(CWM_RK, u, u, rk);
            }
            {
                const int i = (u == 0) ? 1 : (u == 3 ? 3 : 2), j = u >> 1;
                bf16x8 xb[2], xk[2], ya[2], yr[2]; LD2(xb, CW_BH, j); LD2(xk, CW_KH, j); LD2(ya, CW_AT, i); LD2(yr, CW_RT, i);
                PUTM(CWM_AB, i, j, MM2(xb, ya)); PUTM(CWM_AK, i, j, MM2(xk, ya)); PUTM(CWM_RB, i, j, MM2(xb, yr)); PUTM(CWM_RK, i, j, MM2(xk, yr));
            }
            {
                const int j = (u < 2) ? 0 : 2;
                bf16x8 xb[2], xk[2], y[2]; LD2(xb, CW_BH, j); LD2(xk, CW_KH, j);
                if (u & 1) { LD2(y, CW_RT, 3); PUTM(CWM_RB, 3, j, MM2(xb, y)); PUTM(CWM_RK, 3, j, MM2(xk, y)); }
                else       { LD2(y, CW_AT, 3); PUTM(CWM_AB, 3, j, MM2(xb, y)); PUTM(CWM_AK, 3, j, MM2(xk, y)); }
            }
        }
        LDS_BARRIER();
        {
            const int kind = wave >> 2, st = wave & 3;
            unsigned char* gpq = a.ws + WS_POOL + PO_CWPQ + (size_t)ci * 16384; unsigned char* gro = a.ws + WS_POOL + PO_CWRO + (size_t)ci * 16384;
#define FM64(base, i, j) (*(const LAS bf16x4*)(lds + (base) + (((i) * 2 + ((j) >> 1)) * 64 + lane) * 16 + ((j) & 1) * 8))
#define FM128(base, i, jp) (*(const LAS bf16x8*)(lds + (base) + (((i) * 2 + (jp)) * 64 + lane) * 16))
#define MFP(A8, B8, C) MF32(A8, B8, C)
#define LTRI(OUT, base, ACC, B01, B23) do { \
                OUT[0] = MFP(FM128(base, 0, 0), B01, ACC[0]); OUT[1] = MFP(FM128(base, 1, 0), B01, ACC[1]); \
                OUT[2] = MFP(FM128(base, 2, 1), B23, MFP(FM128(base, 2, 0), B01, ACC[2])); OUT[3] = MFP(FM128(base, 3, 1), B23, MFP(FM128(base, 3, 0), B01, ACC[3])); } while (0)
#define LTRIT(OUT, base, ACC, A01, A23) do { \
                OUT[0] = MFP(A01, FM128(base, 0, 0), ACC[0]); OUT[1] = MFP(A01, FM128(base, 1, 0), ACC[1]); \
                OUT[2] = MFP(A23, FM128(base, 2, 1), MFP(A01, FM128(base, 2, 0), ACC[2])); OUT[3] = MFP(A23, FM128(base, 3, 1), MFP(A01, FM128(base, 3, 0), ACC[3])); } while (0)
            bf16x4 ft[4];
#pragma unroll
            for (int i = 0; i < 4; ++i) ft[i] = *(const LAS bf16x4*)(lds + CWT + (i * 64 + lane) * 8);
            const bf16x4 ab10 = FM64(CWM_AB, 1, 0); const bf16x8 ab2 = FM128(CWM_AB, 2, 0), ab3 = FM128(CWM_AB, 3, 0), ab3h = FM128(CWM_AB, 3, 1);
            f32x4 R[4]; bf16x8 vf[2] = {};
            if (kind == 0) { const bf16x8 r01 = FM128(CWF_AT, st, 0), r23 = FM128(CWF_AT, st, 1); R[0] = up4(lo4(r01)); R[1] = up4(hi4(r01)); R[2] = up4(lo4(r23)); R[3] = up4(hi4(r23)); }
            else { vf[0] = FM128(CWF_V, st, 0); vf[1] = FM128(CWF_V, st, 1); const f32x4 zz[4] = {Z0, Z0, Z0, Z0}; LTRI(R, CWM_AK, zz, vf[0], vf[1]); }
            bf16x4 c[4];
            c[0] = cvt4(MF16(ft[0], cvt4(R[0]), Z0));
            c[1] = cvt4(MF16(ft[1], cvt4(MF16(ab10, c[0], R[1])), Z0));
            const bf16x8 c01 = cat8(c[0], c[1]);
            c[2] = cvt4(MF16(ft[2], cvt4(MFP(ab2, c01, R[2])), Z0));
            c[3] = cvt4(MF16(ft[3], cvt4(MFP(ab3h, cat8(c[2], c[2]), MFP(ab3, c01, R[3]))), Z0));
            const bf16x8 c23 = cat8(c[2], c[3]);
            const int col = 16 * st + fr;
            if (kind == 0) {
                const f32x4 er4 = *(const LAS f32x4*)(side + 512 + 16 * st + 4 * fq);
                f32x4 xr[4];
#pragma unroll
                for (int i = 0; i < 4; ++i) xr[i] = up4(*(const LAS bf16x4*)(IMG(CW_RT) + (16 * i + fr) * CW_S + (16 * st + 4 * fq) * 2)) * er4;
                LTRIT(xr, CWM_RB, xr, c01, c23);
#pragma unroll
                for (int i = 0; i < 4; ++i) {
                    const f32x4 xp = MFP(c23, FM128(CWF_BH, i, 1), MFP(c01, FM128(CWF_BH, i, 0), Z0));
                    const float etr = side[640 + 16 * i + fr], etot = side[576 + 16 * i + fr];
                    f32x4 pv;
#pragma unroll
                    for (int r = 0; r < 4; ++r) pv[r] = xp[r] * etr + ((i == st && 4 * fq + r == fr) ? etot : 0.f);
                    *(bf16x4*)(gro + ((i * 2 + (st >> 1)) * 64 + lane) * 16 + (st & 1) * 8) = cvt4(xr[i]);
                    *(bf16x4*)(gpq + ((i * 2 + (st >> 1)) * 64 + lane) * 16 + (st & 1) * 8) = cvt4(pv);
                }
            } else {
                f32x4 xo[4]; { const f32x4 zz[4] = {Z0, Z0, Z0, Z0}; LTRI(xo, CWM_RB, zz, c01, c23); }
                LTRI(xo, CWM_RK, xo, vf[0], vf[1]);
#pragma unroll
                for (int i = 0; i < 4; ++i) {
                    f32x4 xq = MFP(FM128(CWF_BH, i, 1), c23, MFP(FM128(CWF_BH, i, 0), c01, Z0));
                    xq = MFP(FM128(CWF_KH, i, 1), vf[1], MFP(FM128(CWF_KH, i, 0), vf[0], xq));
                    u32x2 w; w.x = pk2(xo[i][0], xo[i][1]); w.y = pk2(xo[i][2], xo[i][3]); *(u32x2*)(gro + 8192 + ((i * 4 + st) * 64 + lane) * 8) = w;
                    const f32x4 et4 = *(const LAS f32x4*)(side + 640 + 16 * i + 4 * fq);
                    w.x = pk2(xq[0] * et4[0], xq[1] * et4[1]); w.y = pk2(xq[2] * et4[2], xq[3] * et4[3]);
                    *(u32x2*)(gpq + 8192 + ((i * 4 + st) * 64 + lane) * 8) = w;
                }
            }
#undef FM64
#undef FM128
#undef MFP
#undef LTRI
#undef LTRIT
        }
#undef LD2
#undef MM2
#undef PUTM
    }
#undef IMG
#undef RW1_LOAD
#undef BFS
}
template <int PART> DEV void mpost_tokens(KA& a, int l, int n_lo, int n_hi, int w0, int wstride, const bool dum);
constexpr int RW2_POST_TOK = 10880;
DEV void phase_rw2(KA& a, LAS unsigned char* lds, int l, const bool dum = false) {
    const int tid = opaque_tid(), lane = tid & 63, wave = __builtin_amdgcn_readfirstlane(tid >> 6), G = gridDim.x, wg = blockIdx.x;
    const int fr = lane & 15, fq = lane >> 4, mt = wave >> 1, nt0 = 2 * (wave & 1);
    constexpr int RING = 16384, SLOT = 32768;
    static_assert(RING + 4 * SLOT <= LDS_MISC, "RW2 LDS map");
    for (int item = wg; item < 256; item += G) {
        const int qd = 3 - (item >> 6), bh = item & 63, h = bh & 7, b = bh >> 3, hb = h >> 2, cb = (h & 3) * 64;
        const int nsteps = 16 * qd + 16, c_out = 16 * qd;
        bf16_t* op = pool_blk(a, (dum ? 30 : BK_RWO) + hb) + cb;
        const unsigned char* gpq = a.ws + WS_POOL + PO_CWPQ + (size_t)bh * 64 * 16384 + tid * 16; const unsigned char* gro = a.ws + WS_POOL + PO_CWRO + (size_t)bh * 64 * 16384 + tid * 16;
        __syncthreads();
        for (int i = tid; i < 2 * 8192 / 4; i += 512) ((LAS unsigned*)lds)[i] = 0u;
#define RW2_ISSUE(s) do { const int s_ = (s); const int r_ = s_ < nsteps ? s_ : nsteps - 1; LAS unsigned char* d_ = lds + RING + (s_ & 3) * SLOT + wave * 1024; \
            const unsigned char* p_ = gpq + (size_t)r_ * 16384; \
            __builtin_amdgcn_global_load_lds((const unsigned*)p_, (LAS unsigned*)d_, 16, 0, 0); __builtin_amdgcn_global_load_lds((const unsigned*)(p_ + 8192), (LAS unsigned*)(d_ + 8192), 16, 0, 0); \
            if (s_ >= c_out) { const unsigned char* q_ = gro + (size_t)r_ * 16384; \
                __builtin_amdgcn_global_load_lds((const unsigned*)q_, (LAS unsigned*)(d_ + 16384), 16, 0, 0); __builtin_amdgcn_global_load_lds((const unsigned*)(q_ + 8192), (LAS unsigned*)(d_ + 24576), 16, 0, 0); } } while (0)
        RW2_ISSUE(0); RW2_ISSUE(1); RW2_ISSUE(2);
        asm volatile("s_waitcnt vmcnt(4)" ::: "memory");
        LDS_BARRIER();
        for (int c = 0; c < nsteps; ++c) {
            RW2_ISSUE(c + 3);
            const LAS unsigned char* Hc = lds + (c & 1) * 8192; LAS unsigned char* Hn = lds + ((c + 1) & 1) * 8192;
            const LAS unsigned char* sl = lds + RING + (c & 3) * SLOT;
            bf16x8 hb0[2], hb1[2];
            hb0[0] = *(const LAS bf16x8*)(Hc + ((nt0 * 2) * 64 + lane) * 16); hb0[1] = *(const LAS bf16x8*)(Hc + ((nt0 * 2 + 1) * 64 + lane) * 16);
            hb1[0] = *(const LAS bf16x8*)(Hc + ((nt0 * 2 + 2) * 64 + lane) * 16); hb1[1] = *(const LAS bf16x8*)(Hc + ((nt0 * 2 + 3) * 64 + lane) * 16);
            const bf16x8 paf0 = *(const LAS bf16x8*)(sl + ((mt * 2) * 64 + lane) * 16), paf1 = *(const LAS bf16x8*)(sl + ((mt * 2 + 1) * 64 + lane) * 16);
            f32x4 hn[2];
            hn[0] = up4(*(const LAS bf16x4*)(sl + 8192 + ((mt * 4 + nt0) * 64 + lane) * 8)); hn[1] = up4(*(const LAS bf16x4*)(sl + 8192 + ((mt * 4 + nt0 + 1) * 64 + lane) * 8));
            hn[0] = __builtin_amdgcn_mfma_f32_16x16x32_bf16(paf0, hb0[0], hn[0], 0, 0, 0); hn[0] = __builtin_amdgcn_mfma_f32_16x16x32_bf16(paf1, hb0[1], hn[0], 0, 0, 0);
            hn[1] = __builtin_amdgcn_mfma_f32_16x16x32_bf16(paf0, hb1[0], hn[1], 0, 0, 0); hn[1] = __builtin_amdgcn_mfma_f32_16x16x32_bf16(paf1, hb1[1], hn[1], 0, 0, 0);
            *(LAS bf16x4*)(Hn + ((nt0 * 2 + (mt >> 1)) * 64 + lane) * 16 + (mt & 1) * 8) = cvt4(hn[0]); *(LAS bf16x4*)(Hn + ((nt0 * 2 + 2 + (mt >> 1)) * 64 + lane) * 16 + (mt & 1) * 8) = cvt4(hn[1]);
            if (c >= c_out) {
                const bf16x8 raf0 = *(const LAS bf16x8*)(sl + 16384 + ((mt * 2) * 64 + lane) * 16), raf1 = *(const LAS bf16x8*)(sl + 16384 + ((mt * 2 + 1) * 64 + lane) * 16);
                f32x4 o[2];
                o[0] = up4(*(const LAS bf16x4*)(sl + 24576 + ((mt * 4 + nt0) * 64 + lane) * 8)); o[1] = up4(*(const LAS bf16x4*)(sl + 24576 + ((mt * 4 + nt0 + 1) * 64 + lane) * 8));
                o[0] = __builtin_amdgcn_mfma_f32_16x16x32_bf16(raf0, hb0[0], o[0], 0, 0, 0); o[0] = __builtin_amdgcn_mfma_f32_16x16x32_bf16(raf1, hb0[1], o[0], 0, 0, 0);
                o[1] = __builtin_amdgcn_mfma_f32_16x16x32_bf16(raf0, hb1[0], o[1], 0, 0, 0); o[1] = __builtin_amdgcn_mfma_f32_16x16x32_bf16(raf1, hb1[1], o[1], 0, 0, 0);
                const size_t nb_ = (size_t)b * T + (size_t)c * 64;
#pragma unroll
                for (int j = 0; j < 2; ++j)
#pragma unroll
                    for (int r = 0; r < 4; ++r) op[(nb_ + 16 * mt + 4 * fq + r) * 256 + 16 * (nt0 + j) + fr] = (bf16_t)f2bf(o[j][r]);
            }
            if (c - 2 >= c_out) asm volatile("s_waitcnt vmcnt(32)" ::: "memory"); else asm volatile("s_waitcnt vmcnt(4)" ::: "memory");
            LDS_BARRIER();
        }
#undef RW2_ISSUE
        asm volatile("s_waitcnt vmcnt(0)" ::: "memory");
        LDS_BARRIER();
        { const int nu = 3 - qd, u0 = bh * 6 + (qd == 0 ? 0 : (qd == 1 ? 3 : 5));
          if (nu > 0) mpost_tokens<0>(a, l, (u0 * RW2_POST_TOK) / 384, ((u0 + nu) * RW2_POST_TOK) / 384, wave, 8, dum); }
    }
}

template <int PART> DEV void mpost_tokens(KA& a, int l, int n_lo, int n_hi, int w0, int wstride, const bool dum) {
    const int lane = opaque_tid() & 63;
    const int c0 = 8 * lane, blk = c0 >> 8, col = c0 & 255;
    const float* RK = (const float*)(a.ws + WS_RK);
    float nw[8], lnw[8], lnb[8], muv[8];
#pragma unroll
    for (int j = 0; j < 8; ++j) { nw[j] = FIN(I_HGNW)[l * 128 + (c0 & 127) + j]; lnw[j] = FIN(I_LNW)[l * 512 + c0 + j]; lnb[j] = FIN(I_LNB)[l * 512 + c0 + j]; muv[j] = FIN(I_MU)[l * 1792 + 1024 + c0 + j]; }
#pragma unroll 2
    for (int n = n_lo + w0; n < n_hi; n += wstride) {
        const size_t off = (size_t)n * 256 + col;
        float o[8], g[8], r_[8];
        if (PART == 0) {
        {
            u32x4* op = (u32x4*)(pool_blk(a, BK_HGI + blk) + off);
            unpack8(*op, o); unpack8(*(const u32x4*)(pool_blk(a, BK_HGG + blk) + off), g);
            float ss = 0.f;
#pragma unroll
            for (int j = 0; j < 8; ++j) ss += o[j] * o[j];
            ss = row16_sum(ss);
            const float r = __builtin_amdgcn_rsqf(ss * (1.f / 128.f) + NORM_EPS);
#pragma unroll
            for (int j = 0; j < 8; ++j) r_[j] = o[j] * r * nw[j] * silu(g[j]);
            *(dum ? (u32x4*)(pool_blk(a, 16 + blk) + off) : op) = pack8(r_);
        }
        {
            u32x4* op = (u32x4*)(pool_blk(a, BK_RTV + blk) + off);
            unpack8(*op, o); unpack8(*(const u32x4*)(pool_blk(a, BK_RTG + blk) + off), g);
            float ss = 0.f;
#pragma unroll
            for (int j = 0; j < 8; ++j) ss += o[j] * o[j];
            ss = row16_sum(ss);
            const float r = __builtin_amdgcn_rsqf(ss * (1.f / 128.f) + NORM_EPS);
#pragma unroll
            for (int j = 0; j < 8; ++j) r_[j] = o[j] * r * silu(g[j]);
            *(dum ? (u32x4*)(pool_blk(a, 18 + blk) + off) : op) = pack8(r_);
        }
        } else {
            float v0[8], vp[8];
            unpack8(*(const u32x4*)(pool_blk(a, BK_RWO + blk) + off), o);
            u32x4* gp = (u32x4*)(pool_blk(a, BK_LG + blk) + off);
            unpack8(*gp, g);
            unpack8(*(const u32x4*)(pool_blk(a, BK_RWV + blk) + off), v0);
            if ((n & (T - 1)) > 0) unpack8(*(const u32x4*)(pool_blk(a, BK_RWV + blk) + off - 256), vp);
            else {
#pragma unroll
                for (int j = 0; j < 8; ++j) vp[j] = 0.f; }
            float s = 0.f;
#pragma unroll
            for (int j = 0; j < 8; ++j) s += o[j];
            const float mean = row8_sum(s) * (1.f / 64.f);
            float q = 0.f;
#pragma unroll
            for (int j = 0; j < 8; ++j) { const float dd = o[j] - mean; q += dd * dd; }
            const float var = row8_sum(q) * (1.f / 64.f);
            const float rs = __builtin_amdgcn_rsqf(var + RW_GN_EPS);
            const float rk = RK[(size_t)n * 8 + (lane >> 3)];
#pragma unroll
            for (int j = 0; j < 8; ++j) { const float vs = v0[j] + muv[j] * (vp[j] - v0[j]); r_[j] = ((o[j] - mean) * rs * lnw[j] + lnb[j] + rk * vs) * g[j]; }
            *(dum ? (u32x4*)(pool_blk(a, 8 + blk) + off) : gp) = pack8(r_);
        }
    }
}
DEV void phase_mpost(KA& a, int l, const bool dum = false) {
    const int wave = opaque_tid() >> 6;
    mpost_tokens<1>(a, l, 0, NTOK, blockIdx.x * 8 + wave, gridDim.x * 8, dum);
    mpost_tokens<0>(a, l, RW2_POST_TOK, NTOK, blockIdx.x * 8 + wave, gridDim.x * 8, dum);
}

DEV void phase_gather(KA& a, LAS unsigned char* lds) {
    const int tid = opaque_tid(), lane = tid & 63, wave = tid >> 6, G = gridDim.x, wg = blockIdx.x;
    LAS int* tot = (LAS int*)lds; LAS int* base = tot + 32; LAS int* se = tot + 64; LAS int* part = tot + 64 + 256;
    const int* cnt = (const int*)(a.ws + WS_CNT); const int* sele = (const int*)(a.ws + WS_SEL_E); int* selp = (int*)(a.ws + WS_SEL_P);
    int* tilemap = (int*)(a.ws + WS_TILEMAP); int* rowtok = (int*)(a.ws + WS_ROWTOK);
    for (int grp = wg; grp < NTOK / 128; grp += G) {
        __syncthreads();
        {
            const int e = tid & 31, pt = tid >> 5; int t_ = 0, bf = 0;
#pragma unroll
            for (int i = 0; i < 16; ++i) { const int g = pt * 16 + i; const int cval = cnt[g * 32 + e]; t_ += cval; bf += (g < grp) ? cval : 0; }
            part[pt * 32 + e] = t_; part[512 + pt * 32 + e] = bf; }
        if (tid < 256) se[tid] = sele[grp * 256 + tid];
        __syncthreads();
        if (tid < 64) {
            const int e = lane & 31; int t_ = 0, bf = 0;
#pragma unroll
            for (int i = 0; i < 16; ++i) { t_ += part[i * 32 + e]; bf += part[512 + i * 32 + e]; }
            const int mt = (t_ + 255) >> 8; int incl = mt;
#pragma unroll
            for (int d = 1; d < 32; d <<= 1) { const int v = __builtin_amdgcn_ds_bpermute(((lane - d) & 63) * 4, incl); if (e >= d) incl += v; }
            const int excl = incl - mt;
            if (lane < 32) { tot[e] = t_; base[e] = bf + excl * 256;
                if (grp == 0) { for (int k = 0; k < mt; ++k) tilemap[1 + excl + k] = e; if (e == 31) tilemap[0] = incl; } } }
        __syncthreads();
#pragma unroll
        for (int q = 0; q < 4; ++q) { const int e = wave * 4 + q; int run = base[e];
#pragma unroll
            for (int k = 0; k < 4; ++k) { const int i = 64 * k + lane; const bool hit = se[i] == e; const unsigned long long m = __ballot(hit);
                if (hit) { const int p = run + (int)__builtin_amdgcn_mbcnt_hi((unsigned)(m >> 32), __builtin_amdgcn_mbcnt_lo((unsigned)m, 0u)); selp[grp * 256 + i] = p; rowtok[p] = grp * 128 + (i >> 1); }
                run += __popcll(m); } }
        if (grp == 0) {
            for (int e = 0; e < 32; ++e) { const int cnt_e = tot[e], end_e = ((cnt_e + 255) >> 8) << 8; for (int p = cnt_e + tid; p < end_e; p += 512) rowtok[base[e] + p] = 0; } }
        __syncthreads();
    }
}

constexpr int PH_PER_LAYER = 17, PH_FINAL = 1 + 2 * PH_PER_LAYER, PH_COUNT = PH_FINAL + 1;
#ifndef MK_PHMASK
#define MK_PHMASK 0x7ffffull
#endif
#define IN(k) (lo <= (k) && (k) < hi)
#define PH(k, idx) (IN(k) && ((MK_PHMASK >> (idx)) & 1ull))
#ifndef MK_REP_IDX
#define MK_REP_IDX -1
#endif
#ifndef MK_REP_L
#define MK_REP_L -1
#endif
#define REP(idx) for (int rep_ = 0; rep_ < ((MK_REP_IDX == (idx) && (MK_REP_L < 0 || MK_REP_L == l)) ? 2 : 1); ++rep_)
#define SEAM(k) do { if (IN(k) && IN((k) + 1)) xcd_barrier(bar); } while (0)
#define KARGS() (*({ KA* ap_ = (KA*)__builtin_amdgcn_kernarg_segment_ptr(); asm volatile("" : "+s"(ap_)); ap_; }))
#define POOL ((bf16_t*)(a.ws + WS_POOL))
#define HBUF ((bf16_t*)(a.ws + WS_H))
template <int L> DEV void run_layer(LAS unsigned char* lds, const int lo, const int hi, const XcdBarrier& bar) {
    constexpr int l = L;
    const int G = gridDim.x, wg = blockIdx.x;
        const int pb = 1 + PH_PER_LAYER * l;
#define WINT ((const bf16_t*)(a.ws + WS_WIN) + (size_t)l * INC * 1024)
        if (PH(pb + 0, 0)) REP(0) { KA& a = KARGS(); if (l == 0) phase_norm<0>(a, lds, 0); else phase_norm<1>(a, lds, l); }
        SEAM(pb + 0);
        if (PH(pb + 1, 1)) REP(1) { KA& a = KARGS(); pg8::Gemm g{HBUF, WINT, 1024, 1024, 512, 0, 0}; pg8::DenseOrder S; S.init(NTOK, ZMIXC, G, wg, 0); pg8::EpiBlk<0, 0> E{POOL};
            pg8::gemm_phase(lds, g, S, E); }
        SEAM(pb + 1);
        if (PH(pb + 2, 2)) REP(2) { KA& a = KARGS(); phase_mpre(a, lds, l, MK_REP_IDX == 2 && rep_ == 0); }
        SEAM(pb + 2);
        if (PH(pb + 3, 3)) REP(3) { KA& a = KARGS(); pg8::Gemm g{pool_blk(a, BK_LIN), (const bf16_t*)(a.ws + WS_LORAB) + (size_t)l * 1536 * 256, 256, 256, 512, 0, 0}; pg8::DenseOrder S; S.init(NTOK, 1536, G, wg, 0); pg8::EpiBlk<1, 0> E{POOL};
            pg8::gemm_phase(lds, g, S, E); }
        if (PH(pb + 4, 4)) REP(4) { KA& a = KARGS();
            phase_scan_chunk(a, lds, l, MK_REP_IDX == 4 && rep_ == 0);
        }
        SEAM(pb + 4);
        if (PH(pb + 5, 5)) REP(5) { KA& a = KARGS(); phase_rw1(a, lds, l); }
        SEAM(pb + 5);
        if (PH(pb + 6, 6)) REP(6) { KA& a = KARGS(); phase_rw2(a, lds, l, MK_REP_IDX == 6 && rep_ == 0); }
        SEAM(pb + 6);
        if (PH(pb + 7, 7)) REP(7) { KA& a = KARGS(); phase_mpost(a, l, MK_REP_IDX == 7 && rep_ == 0); }
        SEAM(pb + 7);
        if (PH(pb + 8, 8)) REP(8) { KA& a = KARGS(); pg8::Gemm g{HBUF, WINT, 1024, 1024, 512, 0, 0}; pg8::DenseOrder S; S.init(NTOK, GATEC, G, wg, ZMIXC / 256); pg8::EpiBlk<2, 1> E{POOL};
            pg8::gemm_phase(lds, g, S, E); }
        SEAM(pb + 8);
        {
#define YF32 ((float*)pool_blk(a, BK_YF))
#define YBF ((bf16_t*)pool_blk(a, BK_YB))
#define BRT ((const bf16_t*)(a.ws + WS_BR) + (size_t)l * 1024 * 1536)
            if (PH(pb + 9, 9)) REP(9) { KA& a = KARGS(); pg8::Gemm g{pool_blk(a, BK_HGI), BRT, 1536, 256, BLK_B, (size_t)(BK_RTV - BK_HGI) * BLK_B, (size_t)(BK_LG - BK_HGI) * BLK_B}; pg8::DenseOrder S; S.init(NTOK, 1024, G, wg, 0);
                pg8::EpiHorner E{POOL, YBF};
                pg8::gemm_phase<true>(lds, g, S, E); }
            SEAM(pb + 11);
        }
        if (PH(pb + 12, 12)) REP(12) { KA& a = KARGS(); pg8::Gemm g{pool_blk(a, BK_YB), (const bf16_t*)(a.ws + WS_WOUT) + (size_t)l * 1024 * 1024, 1024, 256, BLK_B, 0, 0}; pg8::DenseOrder S; S.init(NTOK, 1024, G, wg, 0);
            if (l == 0) { pg8::EpiResid<true> E{FIN(I_X), (bf16_t*)a.out, (const float*)(a.ws + WS_MOD) + (size_t)l * 8 * 6144 + 2048}; pg8::gemm_phase(lds, g, S, E); }
            else { pg8::EpiResid<false> E{nullptr, (bf16_t*)a.out, (const float*)(a.ws + WS_MOD) + (size_t)l * 8 * 6144 + 2048}; pg8::gemm_phase(lds, g, S, E); } }
        SEAM(pb + 12);
        if (PH(pb + 13, 13)) REP(13) { KA& a = KARGS(); phase_norm<2>(a, lds, l); }
        SEAM(pb + 13);
        if (PH(pb + 14, 14)) REP(14) { KA& a = KARGS(); phase_gather(a, lds); }
        SEAM(pb + 14);
        if (PH(pb + 15, 15)) REP(15) { KA& a = KARGS(); pg8::Gemm g{HBUF, (const bf16_t*)(a.ws + WS_POOL + PO_W13), 1024, 1024, 512, 0, 0}; pg8::MoeOrder S; S.init((const int*)(a.ws + WS_TILEMAP), G, (G % 8 == 0) ? (wg % 8) * (G / 8) + wg / 8 : wg, (const int*)(a.ws + WS_ROWTOK));
            pg8::EpiSwiglu E{(bf16_t*)(a.ws + WS_POOL + PO_ACT)};
            pg8::gemm_phase<false, true>(lds, g, S, E); }
        SEAM(pb + 15);
        if (PH(pb + 16, 16)) REP(16) { KA& a = KARGS(); pg8::Gemm g{(const bf16_t*)(a.ws + WS_POOL + PO_ACT), (const bf16_t*)(a.ws + WS_POOL + PO_W2), 512, 512, 512, 0, 0}; pg8::MoeOrder S; S.init((const int*)(a.ws + WS_TILEMAP), G, (G % 8 == 0) ? (wg % 8) * (G / 8) + wg / 8 : wg);
            pg8::EpiRowBf16 E{(bf16_t*)(a.ws + WS_POOL + PO_Y2), 1024};
            pg8::gemm_phase(lds, g, S, E); }
        SEAM(pb + 16);
    }
__global__ void __launch_bounds__(512, 2) mk_fwd(Args a_unused) {
    extern __shared__ __attribute__((aligned(16))) unsigned char lds_raw[];
    LAS unsigned char* lds = (LAS unsigned char*)lds_raw;
    volatile LAS unsigned* misc = (volatile LAS unsigned*)(lds + LDS_MISC);
    if (threadIdx.x < 16) misc[threadIdx.x] = 0u;
    __syncthreads();
    int lo, hi; XcdBarrier bar;
    { KA& a = KARGS(); lo = a.ph_lo; hi = a.ph_hi; bar.bar = (unsigned*)(a.ws + WS_CTL); bar.x = 0; bar.st = misc;
      if (hi - lo > 1) bar = xcd_barrier_post((unsigned*)(a.ws + WS_CTL), misc); }

    constexpr int l = 0;
    if (PH(0, 17)) REP(17) { KA& a = KARGS(); phase_prologue(a, lds); }
    SEAM(0);
    run_layer<0>(lds, lo, hi, bar);
    run_layer<1>(lds, lo, hi, bar);
    if (PH(PH_FINAL, 18)) REP(18) { KA& a = KARGS(); phase_norm<3>(a, lds, 0); }
#undef IN
#undef PH
#undef SEAM
}

extern "C" void kernel_launch(void* const* d_in, const int* in_sizes, int n_in, void* d_out, int out_size, void* d_ws, size_t ws_size, hipStream_t stream) {
    static int grid = 0;
    if (grid == 0) {
        if (n_in != 31 || in_sizes[0] != NTOK * D || out_size != NTOK * D || ws_size < WS_END) {
            fprintf(stderr, "kernel_launch: unexpected shapes (n_in %d, in0 %d, out %d, ws %zu; need ws >= %zu); nothing launched\n", n_in, n_in > 0 ? in_sizes[0] : -1, out_size, ws_size, (size_t)WS_END); grid = -1; return; }
        int dev = 0, cus = 0, per_cu = 0;
        if (hipGetDevice(&dev) != hipSuccess || hipDeviceGetAttribute(&cus, hipDeviceAttributeMultiprocessorCount, dev) != hipSuccess) { grid = -1; return; }
        if (hipFuncSetAttribute((const void*)mk_fwd, hipFuncAttributeMaxDynamicSharedMemorySize, LDS_BYTES) != hipSuccess) { fprintf(stderr, "kernel_launch: hipFuncSetAttribute failed\n"); grid = -1; return; }
        if (hipOccupancyMaxActiveBlocksPerMultiprocessor(&per_cu, (const void*)mk_fwd, 512, LDS_BYTES) != hipSuccess || per_cu < 1) { fprintf(stderr, "kernel_launch: occupancy query says %d\n", per_cu); grid = -1; return; }
        grid = cus;
    }
    if (grid < 0) return;
    if (hipMemsetAsync((char*)d_ws + WS_CTL, 0, CTL_ZERO_BYTES, stream) != hipSuccess) return;
    Args a{};
    for (int i = 0; i < 31; ++i) a.in[i] = d_in[i];
    a.out = (float*)d_out; a.ws = (unsigned char*)d_ws;
#if MK_LAUNCH_PER_PHASE
    for (int ph = 0; ph < PH_COUNT; ++ph) { a.ph_lo = ph; a.ph_hi = ph + 1; hipLaunchKernelGGL(mk_fwd, dim3(grid), dim3(512), LDS_BYTES, stream, a); }
#else
    a.ph_lo = 0; a.ph_hi = PH_COUNT; hipLaunchKernelGGL(mk_fwd, dim3(grid), dim3(512), LDS_BYTES, stream, a);
#endif
}
```

```cpp
#include <hip/hip_runtime.h>
#include <cstdio>

#define LAS __attribute__((address_space(3)))
#define DEV __device__ __forceinline__
typedef unsigned short bf16_t;
typedef short bf16x8 __attribute__((ext_vector_type(8)));
typedef float f32x4 __attribute__((ext_vector_type(4)));
typedef float f32x2 __attribute__((ext_vector_type(2)));
typedef unsigned u32x4 __attribute__((ext_vector_type(4)));
typedef unsigned u32x2 __attribute__((ext_vector_type(2)));

#ifndef MK_LAUNCH_PER_PHASE
#define MK_LAUNCH_PER_PHASE 0
#endif

constexpr int NB = 8, T = 4096, D = 1024, NTOK = NB * T, DEPTH = 2;
constexpr int INC = 8960, ZMIXC = 5888, GATEC = 3072;
constexpr int NEXP = 32, DEXP = 512;
constexpr int RMAX = 2 * NTOK + NEXP * 256;
constexpr float NORM_EPS = 1e-6f, RW_GN_EPS = 64e-5f;
constexpr size_t MiB = (size_t)1 << 20;
constexpr size_t BLK_E = (size_t)NTOK * 256;
constexpr size_t BLK_B = BLK_E * 2;

constexpr size_t WS_CTL = 0;
constexpr size_t CTL_ZERO_BYTES = 64 * 1024;
constexpr size_t WS_MODP = 1 * MiB;
constexpr size_t WS_MOD = 4 * MiB;
constexpr size_t WS_LB = 4 * MiB + 512 * 1024;
constexpr size_t WS_HGSIDE = 5 * MiB;
constexpr size_t WS_SEL_E = 8 * MiB;
constexpr size_t WS_SEL_W = WS_SEL_E + 256 * 1024;
constexpr size_t WS_SEL_P = WS_SEL_W + 256 * 1024;
constexpr size_t WS_CNT = WS_SEL_P + 256 * 1024;
constexpr size_t WS_TILEMAP = WS_CNT + 64 * 1024;
constexpr size_t WS_ROWTOK = 9 * MiB;
constexpr size_t WS_RK = 10 * MiB;
constexpr size_t WS_WIN = 16 * MiB;
constexpr size_t WS_BR = 51 * MiB;
constexpr size_t WS_WOUT = 57 * MiB;
constexpr size_t WS_LORAB = 61 * MiB;
constexpr size_t WS_H = 64 * MiB;
constexpr size_t WS_POOL = 128 * MiB;
constexpr size_t WS_END = 640 * MiB;
constexpr int BK_HGQ = 0, BK_HGF = 2, BK_HGI = 4, BK_HGG = 6, BK_RTQ = 8, BK_RTK = 10, BK_RTV = 12, BK_RTG = 14;
constexpr int BK_RWR = 16, BK_RWK = 18, BK_RWV = 20, BK_RWL = 22, BK_LIN = 23, BK_LW = 24, BK_LA = 26, BK_LG = 28, BK_RWO = 30;
constexpr int BK_YF = 16;
constexpr int BK_YB = 24;
constexpr size_t PO_HPERM = 0;
constexpr size_t PO_ACT = 144 * MiB;
constexpr size_t PO_Y2 = 216 * MiB;
constexpr size_t PO_W13 = 360 * MiB;
constexpr size_t PO_W2 = 424 * MiB;

constexpr int LDS_BYTES = 163840;
constexpr int LDS_MISC = 163840 - 64;

DEV float bf2f(unsigned v) { return __uint_as_float(v << 16); }
typedef __bf16 bf16n2 __attribute__((ext_vector_type(2)));
DEV unsigned f2bf(float f) { return (unsigned)__builtin_bit_cast(unsigned short, (__bf16)f); }
DEV unsigned pk2(float lo, float hi) { const f32x2 v = {lo, hi}; return __builtin_bit_cast(unsigned, __builtin_convertvector(v, bf16n2)); }
DEV float sigm(float x) { return __builtin_amdgcn_rcpf(1.f + __expf(-x)); }
DEV float silu(float x) { return x * __builtin_amdgcn_rcpf(1.f + __expf(-x)); }
DEV int opaque_tid() { int t = threadIdx.x; asm volatile("" : "+v"(t)); return t; }
DEV int ld_vec_i(const int* p) { return __hip_atomic_load(p, __ATOMIC_RELAXED, __HIP_MEMORY_SCOPE_AGENT); }
DEV float ld_vec_f(const float* p) { return __hip_atomic_load(p, __ATOMIC_RELAXED, __HIP_MEMORY_SCOPE_AGENT); }
DEV float wave_sum(float v) {
#pragma unroll
    for (int o = 1; o < 64; o <<= 1) v += __shfl_xor(v, o);
    return v;
}
#define LDS_WAIT() asm volatile("s_waitcnt lgkmcnt(0)" ::: "memory")
#define LDS_BARRIER() do { asm volatile("s_waitcnt lgkmcnt(0)" ::: "memory"); __builtin_amdgcn_s_barrier(); asm volatile("" ::: "memory"); } while (0)

#define XB_TMO      128
#define XB_XCNT(j)  (256  + 64 * (j))
#define XB_XSUB(j)  (1280 + 64 * (j))
#define XB_XGEN(j)  (2304 + 64 * (j))
#define XB_TOP      3328
#define XB_TOPGEN   3392
#define XCD_BAR_WORDS 3456
#define XB_SPIN_CAP (1u << 20)

__device__ __forceinline__ unsigned xb_ld(unsigned* p)              { return __hip_atomic_load(p, __ATOMIC_RELAXED, __HIP_MEMORY_SCOPE_AGENT); }
__device__ __forceinline__ unsigned xb_add(unsigned* p, unsigned v) { return __hip_atomic_fetch_add(p, v, __ATOMIC_RELAXED, __HIP_MEMORY_SCOPE_AGENT); }
__device__ __forceinline__ unsigned xb_xcc_id() { return (unsigned)__builtin_amdgcn_s_getreg((3 << 11) | 20) & 0xFu; }
#define XB_SPIN(cond, bar) do { unsigned _sp = 0; while (cond) { __builtin_amdgcn_s_sleep(1); \
    if ((++_sp & 255u) == 0u) { if (xb_ld(&(bar)[XB_TMO])) break; if (_sp > XB_SPIN_CAP) { atomicAdd(&(bar)[XB_TMO], 1u); break; } } } } while (0)

struct XcdBarrier { unsigned* bar; unsigned x; volatile LAS unsigned* st; };

__device__ __forceinline__ XcdBarrier xcd_barrier_post(unsigned* bar, volatile LAS unsigned* st) {
    XcdBarrier b; b.bar = bar; b.x = xb_xcc_id(); b.st = st;
    if (threadIdx.x == 0) (void)xb_add(&bar[XB_XCNT(b.x)], 1u);
    return b;
}
__device__ __forceinline__ void xcd_barrier_complete(unsigned* bar, unsigned x, unsigned& nloc, unsigned& nx) {
    const unsigned G = gridDim.x * gridDim.y * gridDim.z;
    unsigned sum, cnt, mine, sp = 0u;
    for (;;) {
        sum = 0u; cnt = 0u; mine = 0u;
#pragma unroll
        for (unsigned j = 0; j < 16; ++j) { const unsigned c = xb_ld(&bar[XB_XCNT(j)]); sum += c; cnt += (c > 0u) ? 1u : 0u; mine = (j == x) ? c : mine; }
        if (sum == G) break;
        __builtin_amdgcn_s_sleep(1);
        if ((++sp & 255u) == 0u) { if (xb_ld(&bar[XB_TMO])) break; if (sp > XB_SPIN_CAP) { atomicAdd(&bar[XB_TMO], 1u); break; } }
    }
    nloc = mine > 0u ? mine : 1u; nx = cnt > 0u ? cnt : 1u;
}
__device__ __forceinline__ void xcd_barrier(const XcdBarrier& b) {
    asm volatile("s_waitcnt vmcnt(0)" ::: "memory");
    __syncthreads();
    if (threadIdx.x == 0) {
        unsigned* bar = b.bar;
        __builtin_amdgcn_s_waitcnt(0);
        unsigned nloc = b.st[0], nx = b.st[1];
        if (nloc == 0u) { xcd_barrier_complete(bar, b.x, nloc, nx); b.st[0] = nloc; b.st[1] = nx; }
        const unsigned old = xb_add(&bar[XB_XSUB(b.x)], 1u);
        const unsigned gen = old / nloc;
        if (old + 1u == (gen + 1u) * nloc) {
            __builtin_amdgcn_fence(__ATOMIC_RELEASE, "agent");
            asm volatile("s_waitcnt vmcnt(0)" ::: "memory");
            const unsigned og = xb_add(&bar[XB_TOP], 1u);
            const unsigned tg = og / nx;
            if (og + 1u == (tg + 1u) * nx) xb_add(&bar[XB_TOPGEN], 1u);
            else XB_SPIN(xb_ld(&bar[XB_TOPGEN]) == tg, bar);
            __builtin_amdgcn_fence(__ATOMIC_ACQUIRE, "agent");
            xb_add(&bar[XB_XGEN(b.x)], 1u);
            asm volatile("s_waitcnt vmcnt(0)" ::: "memory");
        } else {
            XB_SPIN(xb_ld(&bar[XB_XGEN(b.x)]) == gen, bar);
            __builtin_amdgcn_fence(__ATOMIC_ACQUIRE, "agent");
            asm volatile("s_waitcnt vmcnt(0)" ::: "memory");
        }
    }
    __syncthreads();
}

namespace pg8 {
constexpr int BM = 256, BK = 64, HALF = 128, HTB = HALF * BK * 2, STAGE_BYTES = 8 * HTB, NXCD = 8, WGM = 4;
__host__ __device__ __forceinline__ int lds_byte(int r, int c) { const int st = (r >> 4) * 2 + (c >> 5), rr = r & 15, cc = c & 31, ob = rr * 64 + cc * 2; return st * 1024 + (ob ^ (((ob >> 9) & 1) << 5)); }
__host__ __device__ __forceinline__ void stage_rc(int b, int& R, int& C) { const int st = b / 1024, sb = b % 1024, swz = sb ^ (((sb >> 9) & 1) << 5); R = (st >> 1) * 16 + swz / 64; C = (st & 1) * 32 + (swz % 64) / 2; }
__host__ __device__ __forceinline__ int perm32(int rho) { const int n = rho >> 4, i = rho & 15; return 8 * (i >> 2) + 4 * n + (i & 3); }

struct Unit { int pm, pn, pnb; };
struct Gemm { const bf16_t* A; const bf16_t* Bt; int K; int lda; size_t kblk; size_t seg1, seg2; };

struct DenseOrder {
    static constexpr const int* rowtok = nullptr;
    int nM, nN, nwg, G, c, pnb0, wgm;
    __device__ void init(int M, int N, int G_, int c_, int pnb0_, int wgm_ = WGM) { nM = M / BM; nN = N / BM; nwg = nM * nN; G = G_; c = c_; pnb0 = pnb0_; wgm = wgm_; }
    __device__ bool next(int i, Unit& u) const {
        const long L = (long)i * G + c; if (L >= nwg) return false;
        int wgid = (int)L; { const int q = nwg / NXCD, r = nwg % NXCD, xcd = wgid % NXCD, off = wgid / NXCD; wgid = (xcd < r ? xcd * (q + 1) : r * (q + 1) + (xcd - r) * q) + off; }
        const int nig = wgm * nN, gid = wgid / nig, fm = gid * wgm, gsz = (nM - fm) < wgm ? (nM - fm) : wgm;
        u.pm = fm + ((wgid % nig) % gsz); u.pn = (wgid % nig) / gsz; u.pnb = u.pn + pnb0; return true;
    }
};
struct MoeOrder {
    const int* tilemap; const int* rowtok; int G, c, ntiles;
    __device__ void init(const int* tm, int G_, int c_, const int* rt = nullptr) { tilemap = tm; rowtok = rt; G = G_; c = c_; ntiles = __hip_atomic_load(tm, __ATOMIC_RELAXED, __HIP_MEMORY_SCOPE_AGENT); }
    __device__ bool next(int i, Unit& u) const {
        const int L = i * G + c; if (L >= ntiles * 4) return false;
        const int ti = L >> 2; u.pm = ti; u.pn = L & 3; u.pnb = __hip_atomic_load(tilemap + 1 + ti, __ATOMIC_RELAXED, __HIP_MEMORY_SCOPE_AGENT) * 4 + u.pn; return true;
    }
};

__device__ __forceinline__ unsigned cvt_pk_bf16(float lo, float hi) { return pk2(lo, hi); }

template <bool SEG = false, bool GATH = false, class Epi, class Sched>
__device__ __forceinline__ void gemm_phase(LAS unsigned char* lds, const Gemm g, const Sched& S, const Epi& E) {
    const int tid = opaque_tid(), wid = __builtin_amdgcn_readfirstlane(tid >> 6), lane = tid & 63, wr = wid >> 2, wc = wid & 3, fr = lane & 15, fq = lane >> 4;
    const int K = g.K, nt = K / BK;
    unsigned voffA[2][2], voffN[2][2], voffB[2]; int RA[2], CA[2];
#pragma unroll
    for (int i = 0; i < 2; ++i) { int R, C; stage_rc(tid * 16 + i * 8192, R, C); const int Rb = Epi::PERM ? ((R & ~31) + perm32(R & 31)) : R;
        RA[i] = R; CA[i] = C; voffB[i] = (unsigned)(Rb * K + C) * 2u;
        voffA[0][i] = voffN[0][i] = (unsigned)(R * g.lda + C) * 2u; voffA[1][i] = voffN[1][i] = (unsigned)((R + HALF) * g.lda + C) * 2u; }
    const size_t kstep = (size_t)(BK * 2);
    const size_t hstepA = (size_t)HALF * g.lda * 2, hstepB = (size_t)HALF * K * 2;
    const size_t tstepA = 2 * hstepA, tstepB = 2 * hstepB;
    const size_t kblk = g.kblk;
    const unsigned ldsw = (unsigned)wid * 1024u;
    const int aoff = lds_byte(wr * 64 + fr, fq * 8), boff = lds_byte(wc * 32 + fr, fq * 8);
#define PG8_KOFFA(t) (SEG ? ((((t) >> 3) == 0 ? (size_t)0 : (((t) >> 3) == 1 ? g.seg1 : g.seg2)) + (size_t)(((t) >> 2) & 1) * kblk + (size_t)((t) & 3) * 128) : ((size_t)((t) >> 2) * kblk + (size_t)((t) & 3) * 128))
#define PG8_SA(b, h) (((b) * 2 + (h)) * HTB)
#define PG8_SB(b, h) ((4 + (b) * 2 + (h)) * HTB)
#define PG8_STAGE(bufoff, gbase, voff) do { _Pragma("unroll") for (int _i = 0; _i < 2; ++_i) \
        __builtin_amdgcn_global_load_lds((const unsigned*)((const char*)(gbase) + (voff)[_i]), (LAS unsigned*)(lds + (bufoff) + ldsw + _i * 8192), 16, 0, 0); } while (0)
#define PG8_LDA(dst, b, h) do { _Pragma("unroll") for (int m = 0; m < 4; ++m) _Pragma("unroll") for (int k = 0; k < 2; ++k) dst[m][k] = *(const LAS bf16x8*)(lds + PG8_SA(b, h) + aoff + m * 2048 + k * 1024); } while (0)
#define PG8_LDB(dst, b, h) do { _Pragma("unroll") for (int n = 0; n < 2; ++n) _Pragma("unroll") for (int k = 0; k < 2; ++k) dst[n][k] = *(const LAS bf16x8*)(lds + PG8_SB(b, h) + boff + n * 2048 + k * 1024); } while (0)
#define PG8_MMA(ai, bj, At, Bt) do { __builtin_amdgcn_s_setprio(1); _Pragma("unroll") for (int m = 0; m < 4; ++m) _Pragma("unroll") for (int n = 0; n < 2; ++n) _Pragma("unroll") for (int k = 0; k < 2; ++k) \
        acc[ai][bj][m][n] = __builtin_amdgcn_mfma_f32_16x16x32_bf16(Bt[n][k], At[m][k], acc[ai][bj][m][n], 0, 0, 0); __builtin_amdgcn_s_setprio(0); } while (0)
#define PG8_WAIT_V(n) asm volatile("s_waitcnt vmcnt(" #n ")" ::: "memory")
#define PG8_WAIT_L(n) asm volatile("s_waitcnt lgkmcnt(" #n ")" ::: "memory")
#define PG8_BAR __builtin_amdgcn_s_barrier()
#define PG8_SCHED __builtin_amdgcn_sched_barrier(0)
    Unit cur, nxt; int ui = 0;
    if (!S.next(0, cur)) return;
    f32x4 acc[2][2][4][2];
#pragma unroll
    for (int a = 0; a < 2; ++a)
#pragma unroll
        for (int b = 0; b < 2; ++b)
#pragma unroll
            for (int m = 0; m < 4; ++m)
#pragma unroll
                for (int n = 0; n < 2; ++n) acc[a][b][m][n] = (f32x4){0.f, 0.f, 0.f, 0.f};
    bf16x8 At[4][2], B0[2][2], B1[2][2];
    if constexpr (GATH) {
#pragma unroll
        for (int h_ = 0; h_ < 2; ++h_)
#pragma unroll
            for (int i = 0; i < 2; ++i) voffA[h_][i] = (unsigned)__hip_atomic_load(S.rowtok + cur.pm * BM + h_ * HALF + RA[i], __ATOMIC_RELAXED, __HIP_MEMORY_SCOPE_AGENT) * (unsigned)(g.lda * 2) + (unsigned)CA[i] * 2u; }
    const char* cA = (const char*)g.A + (GATH ? (size_t)0 : (size_t)cur.pm * tstepA); const char* cB = (const char*)g.Bt + (size_t)cur.pnb * tstepB;
    PG8_STAGE(PG8_SB(0, 0), cB, voffB); PG8_STAGE(PG8_SA(0, 0), cA, voffA[0]); PG8_STAGE(PG8_SB(0, 1), cB + hstepB, voffB); PG8_STAGE(PG8_SA(0, 1), cA, voffA[1]);
    if (wr == 1) PG8_BAR;
    PG8_WAIT_V(4); PG8_BAR;
    PG8_STAGE(PG8_SB(1, 0), cB + kstep, voffB); PG8_STAGE(PG8_SA(1, 0), cA + kstep, voffA[0]); PG8_STAGE(PG8_SB(1, 1), cB + hstepB + kstep, voffB);
    PG8_WAIT_V(6); PG8_BAR;
    for (;;) {
        const bool has_next = S.next(ui + 1, nxt);
        if constexpr (GATH) { if (has_next) {
#pragma unroll
            for (int h_ = 0; h_ < 2; ++h_)
#pragma unroll
                for (int i = 0; i < 2; ++i) voffN[h_][i] = (unsigned)__hip_atomic_load(S.rowtok + nxt.pm * BM + h_ * HALF + RA[i], __ATOMIC_RELAXED, __HIP_MEMORY_SCOPE_AGENT) * (unsigned)(g.lda * 2) + (unsigned)CA[i] * 2u; } }
        const char* nA = (has_next && !GATH) ? (const char*)g.A + (size_t)nxt.pm * tstepA : cA; const char* nB = has_next ? (const char*)g.Bt + (size_t)nxt.pnb * tstepB : cB;
        for (int t = 0; t < nt; t += 2) {
            const bool last = (t == nt - 2);
            const char* a1 = cA + PG8_KOFFA(t + 1);
            const char* b1 = cB + (size_t)(t + 1) * kstep; (void)b1;
            const char* a2 = last ? nA : cA + PG8_KOFFA(t + 2); const char* b2 = last ? nB : cB + (size_t)(t + 2) * kstep;
            const char* a3 = a2 + kstep; const char* b3 = b2 + kstep;
            unsigned vo0[2], vo1[2];
#pragma unroll
            for (int i = 0; i < 2; ++i) { vo0[i] = (GATH && last) ? voffN[0][i] : voffA[0][i]; vo1[i] = (GATH && last) ? voffN[1][i] : voffA[1][i]; }
            PG8_LDB(B0, 0, 0); PG8_SCHED; PG8_LDA(At, 0, 0); PG8_STAGE(PG8_SA(1, 1), a1, voffA[1]);
            PG8_WAIT_L(8); PG8_BAR; PG8_WAIT_L(0); PG8_MMA(0, 0, At, B0); PG8_BAR; PG8_SCHED;
            PG8_LDB(B1, 0, 1); PG8_STAGE(PG8_SB(0, 0), b2, voffB);
            PG8_BAR; PG8_WAIT_L(0); PG8_MMA(0, 1, At, B1); PG8_BAR;
            PG8_LDA(At, 0, 1); PG8_STAGE(PG8_SA(0, 0), a2, vo0);
            PG8_BAR; PG8_WAIT_L(0); PG8_MMA(1, 0, At, B0); PG8_BAR; PG8_SCHED;
            PG8_STAGE(PG8_SB(0, 1), b2 + hstepB, voffB);
            PG8_WAIT_V(6); PG8_BAR; PG8_MMA(1, 1, At, B1); PG8_BAR;
            PG8_LDB(B0, 1, 0); PG8_SCHED; PG8_LDA(At, 1, 0); PG8_STAGE(PG8_SA(0, 1), a2, vo1);
            PG8_WAIT_L(8); PG8_BAR; PG8_WAIT_L(0); PG8_MMA(0, 0, At, B0); PG8_BAR; PG8_SCHED;
            PG8_LDB(B1, 1, 1); PG8_STAGE(PG8_SB(1, 0), b3, voffB);
            PG8_BAR; PG8_WAIT_L(0); PG8_MMA(0, 1, At, B1); PG8_BAR;
            PG8_LDA(At, 1, 1); PG8_STAGE(PG8_SA(1, 0), a3, vo0);
            PG8_BAR; PG8_WAIT_L(0); PG8_MMA(1, 0, At, B0); PG8_BAR; PG8_SCHED;
            PG8_STAGE(PG8_SB(1, 1), b3 + hstepB, voffB);
            PG8_WAIT_V(6); PG8_BAR; PG8_MMA(1, 1, At, B1); PG8_BAR;
            if constexpr (SEG) { if (t == 6 || t == 14) E.rescale(acc, cur, t >> 3, wr, wc, fr, fq); }
        }
        E(acc, cur, wr, wc, fr, fq);
        if (!has_next) break;
#pragma unroll
        for (int a = 0; a < 2; ++a)
#pragma unroll
            for (int b = 0; b < 2; ++b)
#pragma unroll
                for (int m = 0; m < 4; ++m)
#pragma unroll
                    for (int n = 0; n < 2; ++n) acc[a][b][m][n] = (f32x4){0.f, 0.f, 0.f, 0.f};
        cur = nxt; cA = nA; cB = nB; ++ui;
        if constexpr (GATH) {
#pragma unroll
            for (int h_ = 0; h_ < 2; ++h_)
#pragma unroll
                for (int i = 0; i < 2; ++i) voffA[h_][i] = voffN[h_][i]; }
    }
    PG8_WAIT_V(0);
    if (wr == 0) PG8_BAR;
    PG8_BAR;
#undef PG8_KOFFA
#undef PG8_SA
#undef PG8_SB
#undef PG8_STAGE
#undef PG8_LDA
#undef PG8_LDB
#undef PG8_MMA
#undef PG8_WAIT_V
#undef PG8_WAIT_L
#undef PG8_BAR
#undef PG8_SCHED
}

template <int MAP, int ACT> struct EpiBlk {
    static constexpr bool PERM = true;
    bf16_t* pool;
    __device__ __forceinline__ int bmap(int pn) const {
        if (MAP == 0) return pn;
        if (MAP == 1) return BK_LW + pn;
        return pn < 4 ? pn : (pn < 10 ? pn + 2 : pn + 4);
    }
    __device__ __forceinline__ void operator()(const f32x4 (&acc)[2][2][4][2], const Unit& u, int wr, int wc, int fr, int fq) const {
        bf16_t* base = pool + (size_t)bmap(u.pn) * BLK_E;
        const int row0 = u.pm * BM + wr * 64 + fr, col0 = wc * 32 + 8 * fq;
#pragma unroll
        for (int ai = 0; ai < 2; ++ai)
#pragma unroll
            for (int m = 0; m < 4; ++m) { bf16_t* rowp = base + (size_t)(row0 + ai * HALF + m * 16) * 256 + col0;
#pragma unroll
                for (int bj = 0; bj < 2; ++bj) { f32x4 v0 = acc[ai][bj][m][0], v1 = acc[ai][bj][m][1];
                    if (ACT == 1) {
#pragma unroll
                        for (int j = 0; j < 4; ++j) { v0[j] = sigm(v0[j]); v1[j] = sigm(v1[j]); } }
                    u32x4 w; w.x = cvt_pk_bf16(v0[0], v0[1]); w.y = cvt_pk_bf16(v0[2], v0[3]); w.z = cvt_pk_bf16(v1[0], v1[1]); w.w = cvt_pk_bf16(v1[2], v1[3]);
                    *(u32x4*)(rowp + bj * HALF) = w; } }
    }
};
struct EpiRowBf16 {
    static constexpr bool PERM = true;
    bf16_t* O; int ldc;
    __device__ __forceinline__ void operator()(const f32x4 (&acc)[2][2][4][2], const Unit& u, int wr, int wc, int fr, int fq) const {
        const int row0 = u.pm * BM + wr * 64 + fr, col0 = u.pn * BM + wc * 32 + 8 * fq;
#pragma unroll
        for (int ai = 0; ai < 2; ++ai)
#pragma unroll
            for (int m = 0; m < 4; ++m) { bf16_t* rowp = O + (size_t)(row0 + ai * HALF + m * 16) * ldc + col0;
#pragma unroll
                for (int bj = 0; bj < 2; ++bj) { const f32x4 v0 = acc[ai][bj][m][0], v1 = acc[ai][bj][m][1];
                    u32x4 w; w.x = cvt_pk_bf16(v0[0], v0[1]); w.y = cvt_pk_bf16(v0[2], v0[3]); w.z = cvt_pk_bf16(v1[0], v1[1]); w.w = cvt_pk_bf16(v1[2], v1[3]);
                    *(u32x4*)(rowp + bj * HALF) = w; } }
    }
};
struct EpiSwiglu {
    static constexpr bool PERM = true;
    bf16_t* O;
    __device__ __forceinline__ void operator()(const f32x4 (&acc)[2][2][4][2], const Unit& u, int wr, int wc, int fr, int fq) const {
        const int row0 = u.pm * BM + wr * 64 + fr, col0 = u.pn * HALF + wc * 32 + 8 * fq;
#pragma unroll
        for (int ai = 0; ai < 2; ++ai)
#pragma unroll
            for (int m = 0; m < 4; ++m) { bf16_t* rowp = O + (size_t)(row0 + ai * HALF + m * 16) * DEXP + col0;
                f32x4 v0, v1;
#pragma unroll
                for (int j = 0; j < 4; ++j) { v0[j] = silu(acc[ai][0][m][0][j]) * acc[ai][1][m][0][j]; v1[j] = silu(acc[ai][0][m][1][j]) * acc[ai][1][m][1][j]; }
                u32x4 w; w.x = cvt_pk_bf16(v0[0], v0[1]); w.y = cvt_pk_bf16(v0[2], v0[3]); w.z = cvt_pk_bf16(v1[0], v1[1]); w.w = cvt_pk_bf16(v1[2], v1[3]);
                *(u32x4*)rowp = w; }
    }
};
template <int MODE> struct EpiBranch {
    static constexpr bool PERM = true;
    float* Y; const bf16_t* pool; bf16_t* yb; int gt0;
    __device__ __forceinline__ int gmap(int t) const { return t < 4 ? t : (t < 10 ? t + 2 : t + 4); }
    __device__ __forceinline__ void operator()(const f32x4 (&acc)[2][2][4][2], const Unit& u, int wr, int wc, int fr, int fq) const {
        const bf16_t* gbase = pool + (size_t)gmap(gt0 + u.pn) * BLK_E;
        const int row0 = u.pm * BM + wr * 64 + fr, colb = wc * 32 + 8 * fq;
#pragma unroll
        for (int ai = 0; ai < 2; ++ai)
#pragma unroll
            for (int m = 0; m < 4; ++m) { const size_t row = (size_t)(row0 + ai * HALF + m * 16);
#pragma unroll
                for (int bj = 0; bj < 2; ++bj) { const int cb = colb + bj * HALF;
                    const u32x4 gw = *(const u32x4*)(gbase + row * 256 + cb);
                    f32x4 g0, g1; g0[0] = bf2f(gw.x & 0xffffu); g0[1] = bf2f(gw.x >> 16); g0[2] = bf2f(gw.y & 0xffffu); g0[3] = bf2f(gw.y >> 16);
                    g1[0] = bf2f(gw.z & 0xffffu); g1[1] = bf2f(gw.z >> 16); g1[2] = bf2f(gw.w & 0xffffu); g1[3] = bf2f(gw.w >> 16);
                    float* yp = Y + row * D + u.pn * BM + cb;
                    f32x4 v0 = acc[ai][bj][m][0] * g0, v1 = acc[ai][bj][m][1] * g1;
                    if (MODE != 0) { v0 += *(const f32x4*)yp; v1 += *(const f32x4*)(yp + 4); }
                    if (MODE != 2) { *(f32x4*)yp = v0; *(f32x4*)(yp + 4) = v1; }
                    else { u32x4 w; w.x = cvt_pk_bf16(v0[0], v0[1]); w.y = cvt_pk_bf16(v0[2], v0[3]); w.z = cvt_pk_bf16(v1[0], v1[1]); w.w = cvt_pk_bf16(v1[2], v1[3]);
                        *(u32x4*)(yb + (size_t)u.pn * BLK_E + row * 256 + cb) = w; } } }
    }
};
struct EpiHorner {
    static constexpr bool PERM = true;
    const bf16_t* pool; bf16_t* yb;
    __device__ __forceinline__ int gmap(int t) const { return t < 4 ? t : (t < 10 ? t + 2 : t + 4); }
    __device__ __forceinline__ void rescale(f32x4 (&acc)[2][2][4][2], const Unit& u, int seg, int wr, int wc, int fr, int fq) const {
        const bf16_t* ga = pool + (size_t)gmap(seg * 4 + u.pn) * BLK_E; const bf16_t* gb = pool + (size_t)gmap(seg * 4 + 4 + u.pn) * BLK_E;
        const int row0 = u.pm * BM + wr * 64 + fr, colb = wc * 32 + 8 * fq;
#pragma unroll
        for (int ai = 0; ai < 2; ++ai)
#pragma unroll
            for (int m = 0; m < 4; ++m) { const size_t row = (size_t)(row0 + ai * HALF + m * 16);
#pragma unroll
                for (int bj = 0; bj < 2; ++bj) { const int cb = colb + bj * HALF;
                    const u32x4 wa = *(const u32x4*)(ga + row * 256 + cb), wb = *(const u32x4*)(gb + row * 256 + cb);
                    const unsigned ua[4] = {wa.x, wa.y, wa.z, wa.w}, ub[4] = {wb.x, wb.y, wb.z, wb.w};
#pragma unroll
                    for (int j = 0; j < 4; ++j) {
                        acc[ai][bj][m][0][j] *= bf2f((ua[j >> 1] >> ((j & 1) * 16)) & 0xffffu) * __builtin_amdgcn_rcpf(bf2f((ub[j >> 1] >> ((j & 1) * 16)) & 0xffffu));
                        acc[ai][bj][m][1][j] *= bf2f((ua[2 + (j >> 1)] >> ((j & 1) * 16)) & 0xffffu) * __builtin_amdgcn_rcpf(bf2f((ub[2 + (j >> 1)] >> ((j & 1) * 16)) & 0xffffu)); } } }
    }
    __device__ __forceinline__ void operator()(const f32x4 (&acc)[2][2][4][2], const Unit& u, int wr, int wc, int fr, int fq) const {
        const bf16_t* gc = pool + (size_t)gmap(8 + u.pn) * BLK_E;
        const int row0 = u.pm * BM + wr * 64 + fr, colb = wc * 32 + 8 * fq;
        u32x4 gwv[2][4][2];
#pragma unroll
        for (int ai = 0; ai < 2; ++ai)
#pragma unroll
            for (int m = 0; m < 4; ++m)
#pragma unroll
                for (int bj = 0; bj < 2; ++bj) gwv[ai][m][bj] = *(const u32x4*)(gc + (size_t)(row0 + ai * HALF + m * 16) * 256 + colb + bj * HALF);
#pragma unroll
        for (int ai = 0; ai < 2; ++ai)
#pragma unroll
            for (int m = 0; m < 4; ++m) { const size_t row = (size_t)(row0 + ai * HALF + m * 16);
#pragma unroll
                for (int bj = 0; bj < 2; ++bj) { const int cb = colb + bj * HALF;
                    const u32x4 gw = gwv[ai][m][bj];
                    f32x4 g0, g1; g0[0] = bf2f(gw.x & 0xffffu); g0[1] = bf2f(gw.x >> 16); g0[2] = bf2f(gw.y & 0xffffu); g0[3] = bf2f(gw.y >> 16);
                    g1[0] = bf2f(gw.z & 0xffffu); g1[1] = bf2f(gw.z >> 16); g1[2] = bf2f(gw.w & 0xffffu); g1[3] = bf2f(gw.w >> 16);
                    const f32x4 v0 = acc[ai][bj][m][0] * g0, v1 = acc[ai][bj][m][1] * g1;
                    u32x4 w; w.x = cvt_pk_bf16(v0[0], v0[1]); w.y = cvt_pk_bf16(v0[2], v0[3]); w.z = cvt_pk_bf16(v1[0], v1[1]); w.w = cvt_pk_bf16(v1[2], v1[3]);
                    *(u32x4*)(yb + (size_t)u.pn * BLK_E + row * 256 + cb) = w; } }
    }
};
template <bool F32IN> struct EpiResid {
    static constexpr bool PERM = true;
    const float* xin32; bf16_t* xb; const float* gate;
    __device__ __forceinline__ void operator()(const f32x4 (&acc)[2][2][4][2], const Unit& u, int wr, int wc, int fr, int fq) const {
        const int row0 = u.pm * BM + wr * 64 + fr, col0 = u.pn * BM + wc * 32 + 8 * fq;
        const float* gp = gate + (size_t)(u.pm / 16) * 6144 + col0;
        f32x4 gv[2][2];
#pragma unroll
        for (int bj = 0; bj < 2; ++bj)
#pragma unroll
            for (int n = 0; n < 2; ++n) gv[bj][n] = *(const f32x4*)(gp + bj * HALF + 4 * n);
#pragma unroll
        for (int ai = 0; ai < 2; ++ai) {
            f32x4 xf[4][2][2]; u32x4 xw[4][2];
#pragma unroll
            for (int m = 0; m < 4; ++m)
#pragma unroll
                for (int bj = 0; bj < 2; ++bj) { const size_t row = (size_t)(row0 + ai * HALF + m * 16); const int col = col0 + bj * HALF;
                    if (F32IN) { xf[m][bj][0] = *(const f32x4*)(xin32 + row * D + col); xf[m][bj][1] = *(const f32x4*)(xin32 + row * D + col + 4); }
                    else xw[m][bj] = *(const u32x4*)(xb + row * (2 * D) + col); }
#pragma unroll
            for (int m = 0; m < 4; ++m) { const size_t row = (size_t)(row0 + ai * HALF + m * 16);
#pragma unroll
                for (int bj = 0; bj < 2; ++bj) { const int col = col0 + bj * HALF;
                    f32x4 x0, x1;
                    if (F32IN) { x0 = xf[m][bj][0]; x1 = xf[m][bj][1]; }
                    else { const u32x4 w = xw[m][bj];
                        x0 = (f32x4){bf2f(w.x & 0xffffu), bf2f(w.x >> 16), bf2f(w.y & 0xffffu), bf2f(w.y >> 16)}; x1 = (f32x4){bf2f(w.z & 0xffffu), bf2f(w.z >> 16), bf2f(w.w & 0xffffu), bf2f(w.w >> 16)}; }
                    x0 += gv[bj][0] * acc[ai][bj][m][0]; x1 += gv[bj][1] * acc[ai][bj][m][1];
                    u32x4 o; o.x = cvt_pk_bf16(x0[0], x0[1]); o.y = cvt_pk_bf16(x0[2], x0[3]); o.z = cvt_pk_bf16(x1[0], x1[1]); o.w = cvt_pk_bf16(x1[2], x1[3]);
                    *(u32x4*)(xb + row * (2 * D) + col) = o; } } }
    }
};
}

struct Args { const void* in[31]; float* out; unsigned char* ws; int ph_lo, ph_hi; };
enum { I_X = 0, I_C, I_POS, I_ADAW, I_ADAB, I_N1G, I_N2G, I_WIN, I_LBT, I_HGNW, I_MU, I_W0, I_W2, I_A0, I_A2, I_G2, I_KK, I_KA, I_RK, I_LNW, I_LNB,
       I_BRHG, I_BRRET, I_BRRW, I_WOUT, I_RG, I_RE, I_MW1, I_MW3, I_MW2, I_FG };
typedef const __attribute__((address_space(4))) Args KA;
#define FIN(i) ((const float*)a.in[i])
DEV bf16_t* pool_blk(KA& a, int blk) { return (bf16_t*)(a.ws + WS_POOL) + (size_t)blk * BLK_E; }

#define DPP_ADD(x, ctrl) x += __builtin_bit_cast(float, __builtin_amdgcn_update_dpp(__builtin_bit_cast(int, x), __builtin_bit_cast(int, x), ctrl, 0xF, 0xF, false))
DEV float row16_sum(float x) { DPP_ADD(x, 0xB1); DPP_ADD(x, 0x4E); DPP_ADD(x, 0x141); DPP_ADD(x, 0x140); return x; }
DEV float row8_sum(float x) { DPP_ADD(x, 0xB1); DPP_ADD(x, 0x4E); DPP_ADD(x, 0x141); return x; }

DEV void transpose_item(const float* W, int N, bf16_t* WT, int ldt, int dst_row0, LAS float* scr, int k0, int n0, int lane) {
#pragma unroll
    for (int i = 0; i < 8; ++i) { const int kk = 8 * i + (lane >> 3), n4 = (lane & 7) * 4;
        const f32x4 v = *(const f32x4*)(W + (size_t)(k0 + kk) * N + n0 + n4);
        scr[kk * 33 + n4] = v[0]; scr[kk * 33 + n4 + 1] = v[1]; scr[kk * 33 + n4 + 2] = v[2]; scr[kk * 33 + n4 + 3] = v[3]; }
    LDS_WAIT(); asm volatile("" ::: "memory");
    const int c = lane & 7;
#pragma unroll
    for (int j = 0; j < 4; ++j) { const int n = (lane >> 3) + 8 * j; const LAS float* s = scr + (8 * c) * 33 + n;
        u32x4 o; o.x = pk2(s[0 * 33], s[1 * 33]); o.y = pk2(s[2 * 33], s[3 * 33]); o.z = pk2(s[4 * 33], s[5 * 33]); o.w = pk2(s[6 * 33], s[7 * 33]);
        *(u32x4*)(WT + (size_t)(dst_row0 + n) * ldt + k0 + 8 * c) = o; }
    LDS_WAIT(); asm volatile("" ::: "memory");
}

DEV void dense_weight_transposes(KA& a, LAS float* scr, int l, int r0, int stride, int lane) {
    for (int r = r0; r < 5760; r += stride) {
        if (r < 4480) { const int kb = r / 280, nb = r % 280;
            transpose_item(FIN(I_WIN) + (size_t)l * 1024 * INC, INC, (bf16_t*)(a.ws + WS_WIN) + (size_t)l * INC * 1024, 1024, nb * 32, scr, kb * 64, nb * 32, lane); }
        else if (r < 4480 + 768) { const int r2 = r - 4480, br = r2 / 256, r3 = r2 % 256, kb = r3 / 32, nb = r3 % 32;
            const float* W = (br == 0 ? FIN(I_BRHG) : (br == 1 ? FIN(I_BRRET) : FIN(I_BRRW))) + (size_t)l * 512 * 1024;
            transpose_item(W, 1024, (bf16_t*)(a.ws + WS_BR) + (size_t)l * 1024 * 1536 + br * 512, 1536, nb * 32, scr, kb * 64, nb * 32, lane); }
        else { const int r4 = r - 5248, kb = r4 / 32, nb = r4 % 32;
            transpose_item(FIN(I_WOUT) + (size_t)l * 1024 * 1024, 1024, (bf16_t*)(a.ws + WS_WOUT) + (size_t)l * 1024 * 1024, 1024, nb * 32, scr, kb * 64, nb * 32, lane); }
    }
}
DEV void phase_prologue(KA& a, LAS unsigned char* lds) {
    const int tid = opaque_tid(), lane = tid & 63, wave = tid >> 6, G = gridDim.x, wg = blockIdx.x;
    LAS float* scr = (LAS float*)(lds + wave * 8448);
    const int gw = wg * 8 + wave, NGW = G * 8;
    if (G == 256) dense_weight_transposes(a, scr, 0, gw, NGW, lane);
    else { dense_weight_transposes(a, scr, 0, gw, NGW, lane); dense_weight_transposes(a, scr, 1, gw, NGW, lane); }
    {
        unsigned* LB = (unsigned*)(a.ws + WS_LORAB);
        for (int p = wg * 512 + tid; p < 2 * 1536 * 128; p += G * 512) {
            const int l = p / (1536 * 128), rem = p % (1536 * 128), n = rem / 128, k = (rem % 128) * 2;
            float v0 = 0.f, v1 = 0.f;
            if (n < 512) { if (k < 64) { v0 = FIN(I_W2)[((size_t)l * 64 + k) * 512 + n]; v1 = FIN(I_W2)[((size_t)l * 64 + k + 1) * 512 + n]; } }
            else if (n < 1024) { if (k >= 64 && k < 128) { v0 = FIN(I_A2)[((size_t)l * 64 + k - 64) * 512 + n - 512]; v1 = FIN(I_A2)[((size_t)l * 64 + k - 63) * 512 + n - 512]; } }
            else { if (k >= 128) { v0 = FIN(I_G2)[((size_t)l * 128 + k - 128) * 512 + n - 1024]; v1 = FIN(I_G2)[((size_t)l * 128 + k - 127) * 512 + n - 1024]; } }
            LB[p] = pk2(v0, v1);
        }
    }
    if (wg == 0) {
        float* LBv = (float*)(a.ws + WS_LB);
        for (int i = tid; i < 512; i += 512) { const float t0 = FIN(I_LBT)[i], t1 = FIN(I_LBT)[512 + i]; LBv[i] = 0.f; LBv[512 + i] = 1.f / (1.f + __expf(t0 - t1)); }
    }
    __syncthreads();
    {
        LAS float* cond = (LAS float*)lds;
        LAS float* red = (LAS float*)(lds + 4096);
        float* modp = (float*)(a.ws + WS_MODP);
        for (int item = wg; item < 384; item += G) {
            const int l = item / 192, s = (item % 192) / 24, cb = item % 24;
            for (int i = tid; i < 1024; i += 512) { const int b = i >> 7, kk = i & 127; cond[i] = silu(FIN(I_C)[b * 1024 + s * 128 + kk]); }
            __syncthreads();
            const int colin = tid & 255, half = tid >> 8, col = cb * 256 + colin;
            float acc[8];
#pragma unroll
            for (int b = 0; b < 8; ++b) acc[b] = 0.f;
            const float* Wp = FIN(I_ADAW) + ((size_t)l * 1024 + s * 128 + half * 64) * 6144 + col;
#pragma unroll 16
            for (int kk = 0; kk < 64; ++kk) { const float w = Wp[(size_t)kk * 6144];
#pragma unroll
                for (int b = 0; b < 8; ++b) acc[b] += cond[b * 128 + half * 64 + kk] * w; }
            if (half == 1) {
#pragma unroll
                for (int b = 0; b < 8; ++b) red[b * 256 + colin] = acc[b]; }
            __syncthreads();
            if (half == 0) {
#pragma unroll
                for (int b = 0; b < 8; ++b) modp[((size_t)(s * 2 + l) * 8 + b) * 6144 + col] = acc[b] + red[b * 256 + colin]; }
            __syncthreads();
        }
    }
}

template <int MODE> DEV void phase_norm(KA& a, LAS unsigned char* lds, int l) {
    const int tid = opaque_tid(), lane = tid & 63, wave = tid >> 6, G = gridDim.x, wg = blockIdx.x;
    LAS float* sc = (LAS float*)lds; LAS float* sh = sc + 1024; LAS float* gn = sc + 2048;
    LAS float* g2 = sc + 3072;
    constexpr int WRS = 1028;
    LAS float* Wr = sc + 3072;
    LAS int* hist = (LAS int*)(lds + 12288 + 36 * WRS * 4);
    static_assert(12288 + 36 * WRS * 4 + 128 <= LDS_MISC, "N2 LDS map");
    const float* modp = (const float*)(a.ws + WS_MODP);
    float* mod = (float*)(a.ws + WS_MOD);
    if (MODE == 0) {
        for (int i = wg * 512 + tid; i < 2 * 8 * 6144; i += G * 512) { const int ll = i / (8 * 6144), rem = i % (8 * 6144), b = rem / 6144, j = rem % 6144;
            float s = FIN(I_ADAB)[ll * 6144 + j];
#pragma unroll
            for (int k = 0; k < 8; ++k) s += modp[((size_t)(k * 2 + ll) * 8 + b) * 6144 + j];
            mod[i] = s; }
    }
    if (MODE == 2) {
        LAS float* scr = (LAS float*)(lds + wave * 8448);
        const int gw = wg * 8 + wave, NGW = G * 8;
        bf16_t* W13T = (bf16_t*)(a.ws + WS_POOL + PO_W13); bf16_t* W2T = (bf16_t*)(a.ws + WS_POOL + PO_W2);
        for (int it = gw; it < NEXP * 768; it += NGW) {
            const int e = it / 768, r = it % 768;
            if (r < 512) { const int w3 = r / 256, r2 = r % 256, kb = r2 / 16, nb = r2 % 16, n0 = nb * 32;
                const float* W = (w3 ? FIN(I_MW3) : FIN(I_MW1)) + ((size_t)l * NEXP + e) * 1024 * 512;
                transpose_item(W, 512, W13T + (size_t)e * 1024 * 1024, 1024, (n0 / 128) * 256 + w3 * 128 + (n0 % 128), scr, kb * 64, n0, lane); }
            else { const int r2 = r - 512, kb = r2 / 32, nb = r2 % 32;
                transpose_item(FIN(I_MW2) + ((size_t)l * NEXP + e) * 512 * 1024, 1024, W2T + (size_t)e * 1024 * 512, 512, nb * 32, scr, kb * 64, nb * 32, lane); }
        }
        __syncthreads();
        for (int i = tid; i < 1024 * 4; i += 512) { const int k = i >> 2, o = i & 3; Wr[o * WRS + k] = FIN(I_RG)[(size_t)l * 4096 + i]; }
        for (int i = tid; i < 1024 * 32; i += 512) { const int k = i >> 5, o = i & 31; Wr[(4 + o) * WRS + k] = FIN(I_RE)[(size_t)l * 32768 + i]; }
        if (tid < 32) hist[tid] = 0;
    }
    const float* xsrc = (MODE == 0) ? FIN(I_X) : a.out;
    const bf16_t* Y2 = (const bf16_t*)(a.ws + WS_POOL + PO_Y2);
    const int* selp = (const int*)(a.ws + WS_SEL_P); const float* selw = (const float*)(a.ws + WS_SEL_W);
    bf16_t* H = (bf16_t*)(a.ws + WS_H);
    for (int grp = wg; grp < NTOK / 128; grp += G) {
        const int b = grp / 32;
        __syncthreads();
        for (int j = tid; j < 1024; j += 512) {
            float scale, shift, gain;
            if (MODE == 0) { float s0 = FIN(I_ADAB)[l * 6144 + j], s1 = FIN(I_ADAB)[l * 6144 + 1024 + j];
#pragma unroll
                for (int k = 0; k < 8; ++k) { s0 += modp[((size_t)(k * 2 + l) * 8 + b) * 6144 + j]; s1 += modp[((size_t)(k * 2 + l) * 8 + b) * 6144 + 1024 + j]; }
                shift = s0; scale = s1; gain = FIN(I_N1G)[l * 1024 + j]; }
            else if (MODE == 1) { shift = mod[((size_t)l * 8 + b) * 6144 + j]; scale = mod[((size_t)l * 8 + b) * 6144 + 1024 + j]; gain = FIN(I_N1G)[l * 1024 + j]; }
            else if (MODE == 2) { shift = mod[((size_t)l * 8 + b) * 6144 + 3072 + j]; scale = mod[((size_t)l * 8 + b) * 6144 + 4096 + j]; gain = FIN(I_N2G)[l * 1024 + j]; }
            else { shift = 0.f; scale = 0.f; gain = FIN(I_FG)[j]; }
            sc[j] = 1.f + scale; sh[j] = shift; gn[j] = gain;
            if (MODE == 1 || MODE == 3) { const int lp = (MODE == 1) ? l - 1 : DEPTH - 1; g2[j] = mod[((size_t)lp * 8 + b) * 6144 + 5120 + j]; }
        }
        __syncthreads();
        const bf16_t* xb = (const bf16_t*)a.out;
#define LOADX(dst, n_) do { if (MODE == 0) { _Pragma("unroll") for (int j = 0; j < 4; ++j) dst[j] = *(const f32x4*)(xsrc + (size_t)(n_) * D + 256 * j + 4 * lane); } \
            else { _Pragma("unroll") for (int j = 0; j < 4; ++j) { const u32x2 w_ = *(const u32x2*)(xb + (size_t)(n_) * (2 * D) + 256 * j + 4 * lane); \
                dst[j] = (f32x4){bf2f(w_.x & 0xffffu), bf2f(w_.x >> 16), bf2f(w_.y & 0xffffu), bf2f(w_.y >> 16)}; } } } while (0)
        constexpr int NBT = (MODE == 0) ? 4 : 2;
        for (int tb = 0; tb < 16; tb += NBT) {
        f32x4 vb_[NBT][4]; int pb0[NBT] = {}, pb1[NBT] = {}; float wb0[NBT] = {}, wb1[NBT] = {}; u32x2 yb0[NBT][4], yb1[NBT][4];
#pragma unroll
        for (int u = 0; u < NBT; ++u) { const int n_ = grp * 128 + wave * 16 + tb + u; LOADX(vb_[u], n_);
            if (MODE == 1 || MODE == 3) { pb0[u] = ld_vec_i(selp + 2 * n_); pb1[u] = ld_vec_i(selp + 2 * n_ + 1); wb0[u] = ld_vec_f(selw + 2 * n_); wb1[u] = ld_vec_f(selw + 2 * n_ + 1); } }
        if (MODE == 1 || MODE == 3) {
#pragma unroll
            for (int u = 0; u < NBT; ++u)
#pragma unroll
                for (int j = 0; j < 4; ++j) { const int c = 256 * j + 4 * lane; yb0[u][j] = *(const u32x2*)(Y2 + (size_t)pb0[u] * D + c); yb1[u][j] = *(const u32x2*)(Y2 + (size_t)pb1[u] * D + c); } }
#pragma unroll
        for (int u = 0; u < NBT; ++u) {
            const int ti = tb + u; (void)ti;
            const int n = grp * 128 + wave * 16 + tb + u;
            f32x4 v[4];
#pragma unroll
            for (int j = 0; j < 4; ++j) v[j] = vb_[u][j];
            if (MODE == 1 || MODE == 3) {
                const float w0 = wb0[u], w1 = wb1[u];
#pragma unroll
                for (int j = 0; j < 4; ++j) { const int c = 256 * j + 4 * lane;
                    const u32x2 y0 = yb0[u][j], y1 = yb1[u][j];
                    const f32x4 gg = *(const LAS f32x4*)(g2 + c);
                    v[j][0] += gg[0] * (w0 * bf2f(y0.x & 0xffffu) + w1 * bf2f(y1.x & 0xffffu));
                    v[j][1] += gg[1] * (w0 * bf2f(y0.x >> 16) + w1 * bf2f(y1.x >> 16));
                    v[j][2] += gg[2] * (w0 * bf2f(y0.y & 0xffffu) + w1 * bf2f(y1.y & 0xffffu));
                    v[j][3] += gg[3] * (w0 * bf2f(y0.y >> 16) + w1 * bf2f(y1.y >> 16));
                    if (MODE == 1) { u32x2 o_; o_.x = pk2(v[j][0], v[j][1]); o_.y = pk2(v[j][2], v[j][3]); *(u32x2*)((bf16_t*)a.out + (size_t)n * (2 * D) + c) = o_; } }
            }
            float ss = 0.f;
#pragma unroll
            for (int j = 0; j < 4; ++j) ss += (v[j][0] * v[j][0] + v[j][1] * v[j][1]) + (v[j][2] * v[j][2] + v[j][3] * v[j][3]);
            ss = wave_sum(ss);
            const float r = __builtin_amdgcn_rsqf(ss * (1.f / D) + NORM_EPS);
#pragma unroll
            for (int j = 0; j < 4; ++j) { const int c = 256 * j + 4 * lane;
                const f32x4 gg = *(const LAS f32x4*)(gn + c), s1 = *(const LAS f32x4*)(sc + c), s0 = *(const LAS f32x4*)(sh + c);
                v[j] = v[j] * r * gg * s1 + s0;
                if (MODE == 3) *(f32x4*)(a.out + (size_t)n * D + c) = v[j];
                else { u32x2 o; o.x = pk2(v[j][0], v[j][1]); o.y = pk2(v[j][2], v[j][3]); *(u32x2*)(H + (size_t)n * D + c) = o; } }
            if (MODE == 2) {
#define RT_RED(X, N_) do { \
                _Pragma("unroll") for (int o = 0; o < N_; ++o) X[o] += __builtin_bit_cast(float, __builtin_amdgcn_update_dpp(0, __builtin_bit_cast(int, X[o]), 0xB1, 0xF, 0xF, true)); \
                _Pragma("unroll") for (int o = 0; o < N_; ++o) X[o] += __builtin_bit_cast(float, __builtin_amdgcn_update_dpp(0, __builtin_bit_cast(int, X[o]), 0x4E, 0xF, 0xF, true)); \
                _Pragma("unroll") for (int o = 0; o < N_; ++o) X[o] += __builtin_bit_cast(float, __builtin_amdgcn_update_dpp(0, __builtin_bit_cast(int, X[o]), 0x141, 0xF, 0xF, true)); \
                _Pragma("unroll") for (int o = 0; o < N_; ++o) X[o] += __builtin_bit_cast(float, __builtin_amdgcn_update_dpp(0, __builtin_bit_cast(int, X[o]), 0x140, 0xF, 0xF, true)); \
                _Pragma("unroll") for (int o = 0; o < N_; ++o) X[o] += __builtin_bit_cast(float, __builtin_amdgcn_update_dpp(0, __builtin_bit_cast(int, X[o]), 0x142, 0xA, 0xF, false)); \
                _Pragma("unroll") for (int o = 0; o < N_; ++o) X[o] += __builtin_bit_cast(float, __builtin_amdgcn_update_dpp(0, __builtin_bit_cast(int, X[o]), 0x143, 0xC, 0xF, false)); \
                _Pragma("unroll") for (int o = 0; o < N_; ++o) X[o] = __builtin_bit_cast(float, __builtin_amdgcn_readlane(__builtin_bit_cast(int, X[o]), 63)); } while (0)
                float L[4];
#pragma unroll
                for (int o = 0; o < 4; ++o) { float p = 0.f;
#pragma unroll
                    for (int j = 0; j < 4; ++j) { const f32x4 w = *(const LAS f32x4*)(Wr + o * WRS + 256 * j + 4 * lane); p += (v[j][0] * w[0] + v[j][1] * w[1]) + (v[j][2] * w[2] + v[j][3] * w[3]); }
                    L[o] = p; }
                RT_RED(L, 4);
                int gi = 0; float gm = L[0];
#pragma unroll
                for (int o = 1; o < 4; ++o) if (L[o] > gm) { gm = L[o]; gi = o; }
                float gs = 0.f;
#pragma unroll
                for (int o = 0; o < 4; ++o) gs += __expf(L[o] - gm);
                const float gw_ = 1.f / gs;
                float le[8];
                { const LAS float* We = Wr + (4 + gi * 8) * WRS;
#pragma unroll
                  for (int o = 0; o < 8; ++o) { float p = 0.f;
#pragma unroll
                    for (int j = 0; j < 4; ++j) { const f32x4 w = *(const LAS f32x4*)(We + o * WRS + 256 * j + 4 * lane); p += (v[j][0] * w[0] + v[j][1] * w[1]) + (v[j][2] * w[2] + v[j][3] * w[3]); }
                    le[o] = p; } }
                RT_RED(le, 8);
#undef RT_RED
                int i0 = 0; float m0 = le[0];
#pragma unroll
                for (int j = 1; j < 8; ++j) if (le[j] > m0) { m0 = le[j]; i0 = j; }
                int i1 = -1; float m1 = -3.0e38f;
#pragma unroll
                for (int j = 0; j < 8; ++j) if (j != i0 && le[j] > m1) { m1 = le[j]; i1 = j; }
                const float e1 = __expf(m1 - m0), den = 1.f / (1.f + e1);
                if (lane == 0) {
                    int* sele = (int*)(a.ws + WS_SEL_E); float* selwv = (float*)(a.ws + WS_SEL_W);
                    sele[2 * n] = gi * 8 + i0; sele[2 * n + 1] = gi * 8 + i1;
                    selwv[2 * n] = gw_ * den; selwv[2 * n + 1] = gw_ * e1 * den;
                    __hip_atomic_fetch_add(hist + gi * 8 + i0, 1, __ATOMIC_RELAXED, __HIP_MEMORY_SCOPE_WORKGROUP); __hip_atomic_fetch_add(hist + gi * 8 + i1, 1, __ATOMIC_RELAXED, __HIP_MEMORY_SCOPE_WORKGROUP);
                }
            }
        }
        }
        if (MODE == 2) {
            __syncthreads();
            if (tid < 32) { ((int*)(a.ws + WS_CNT))[grp * 32 + tid] = hist[tid]; hist[tid] = 0; }
        }
    }
}

DEV void unpack8(const u32x4 w, float (&f)[8]) { f[0] = bf2f(w.x & 0xffffu); f[1] = bf2f(w.x >> 16); f[2] = bf2f(w.y & 0xffffu); f[3] = bf2f(w.y >> 16);
    f[4] = bf2f(w.z & 0xffffu); f[5] = bf2f(w.z >> 16); f[6] = bf2f(w.w & 0xffffu); f[7] = bf2f(w.w >> 16); }
DEV u32x4 pack8(const float (&f)[8]) { u32x4 w; w.x = pk2(f[0], f[1]); w.y = pk2(f[2], f[3]); w.z = pk2(f[4], f[5]); w.w = pk2(f[6], f[7]); return w; }
DEV void phase_mpre(KA& a, LAS unsigned char* lds, int l, const bool dum = false) {
    const int tid = opaque_tid(), G = gridDim.x, wg = blockIdx.x;
    {
        LAS float* gt = (LAS float*)lds;
        const float* lbv = (const float*)(a.ws + WS_LB) + l * 512;
        float* side = (float*)(a.ws + WS_HGSIDE);
        const int sub = tid >> 8, tg = (tid >> 6) & 3, dp = tid & 63, d = 2 * dp;
        for (int slot = wg; slot < NB * 64 * 2; slot += G) {
            const int item = slot * 2 + sub, b = item >> 8, c = (item >> 2) & 63, h = item & 3;
            bf16_t* zq = pool_blk(a, BK_HGQ + (h >> 1)) + (h & 1) * 128 + d;
            bf16_t* zf = pool_blk(a, BK_HGF + (h >> 1)) + (h & 1) * 128 + d;
            const size_t n0 = (size_t)b * T + c * 64 + tg * 16;
            const float lb0 = lbv[h * 128 + d], lb1 = lbv[h * 128 + d + 1];
            float qv[16][2], kv[16][2], pc[16][2]; float run0 = 0.f, run1 = 0.f;
#pragma unroll
            for (int i = 0; i < 16; ++i) { const unsigned wq = *(const unsigned*)(zq + (n0 + i) * 256), wf = *(const unsigned*)(zf + (n0 + i) * 256);
                const float f0 = lb0 + (1.f - lb0) * sigm(bf2f(wf & 0xffffu)), f1 = lb1 + (1.f - lb1) * sigm(bf2f(wf >> 16));
                qv[i][0] = silu(bf2f(wq & 0xffffu)) * 0.08838834764831845f; qv[i][1] = silu(bf2f(wq >> 16)) * 0.08838834764831845f;
                kv[i][0] = 1.f - f0; kv[i][1] = 1.f - f1;
                run0 += __logf(fmaxf(f0, 1e-30f)); run1 += __logf(fmaxf(f1, 1e-30f)); pc[i][0] = run0; pc[i][1] = run1; }
            __syncthreads();
            *(LAS f32x2*)(gt + (sub * 4 + tg) * 128 + d) = (f32x2){run0, run1};
            __syncthreads();
            const f32x2 g0 = *(const LAS f32x2*)(gt + (sub * 4 + 0) * 128 + d), g1 = *(const LAS f32x2*)(gt + (sub * 4 + 1) * 128 + d), g2_ = *(const LAS f32x2*)(gt + (sub * 4 + 2) * 128 + d), g3 = *(const LAS f32x2*)(gt + (sub * 4 + 3) * 128 + d);
            const f32x2 ref = g0 + g1, tot = ref + g2_ + g3;
            const f32x2 off = tg == 0 ? (f32x2){0.f, 0.f} : (tg == 1 ? g0 : (tg == 2 ? ref : ref + g2_));
#pragma unroll
            for (int i = 0; i < 16; ++i) { const float c0_ = off[0] + pc[i][0], c1_ = off[1] + pc[i][1];
                *(unsigned*)((dum ? zq + 28 * BLK_E : zq) + (n0 + i) * 256) = pk2(qv[i][0] * __expf(c0_ - ref[0]), qv[i][1] * __expf(c1_ - ref[1]));
                *(unsigned*)((dum ? zf + 28 * BLK_E : zf) + (n0 + i) * 256) = pk2(kv[i][0] * __expf(ref[0] - c0_), kv[i][1] * __expf(ref[1] - c1_)); }
            if (tg == 0) { float* sp = side + ((size_t)(b * 64 + c) * 4 + h) * 384 + d;
                *(f32x2*)sp = (f32x2){__expf(ref[0]), __expf(ref[1])}; *(f32x2*)(sp + 128) = (f32x2){__expf(tot[0]), __expf(tot[1])}; *(f32x2*)(sp + 256) = (f32x2){__expf(tot[0] - ref[0]), __expf(tot[1] - ref[1])}; }
        }
    }
    const int* pos = (const int*)a.in[I_POS];
    {
        const int p0 = wg * 512 + tid, h = (p0 >> 3) & 3, g = p0 & 7;
        float invf[8];
#pragma unroll
        for (int j = 0; j < 8; ++j) invf[j] = exp2f(-(float)(2 * (g * 8 + j)) * (13.287712379549449f / 128.f)) * 0.15915494309189535f;
        const int stride = G * 512;
        for (int pb = p0; pb < NTOK * 32; pb += 4 * stride) {
            u32x4 rq1[4], rq2[4], rk1[4], rk2[4]; float fp[4];
#pragma unroll
            for (int u = 0; u < 4; ++u) { const int p = pb + u * stride; if (p < NTOK * 32) { const int n = p >> 5;
                const size_t off = (size_t)n * 256 + (h & 1) * 128 + g * 8;
                const bf16_t* q = pool_blk(a, BK_RTQ + (h >> 1)) + off; const bf16_t* k = pool_blk(a, BK_RTK + (h >> 1)) + off;
                fp[u] = (float)pos[n]; rq1[u] = *(const u32x4*)q; rq2[u] = *(const u32x4*)(q + 64); rk1[u] = *(const u32x4*)k; rk2[u] = *(const u32x4*)(k + 64); } }
#pragma unroll
            for (int u = 0; u < 4; ++u) { const int p = pb + u * stride; if (p < NTOK * 32) { const int n = p >> 5;
                float sn[8], cs[8];
#pragma unroll
                for (int j = 0; j < 8; ++j) { float rev = fp[u] * invf[j]; rev -= floorf(rev); sn[j] = __builtin_amdgcn_sinf(rev); cs[j] = __builtin_amdgcn_cosf(rev); }
                const size_t off = (size_t)n * 256 + (h & 1) * 128 + g * 8;
                bf16_t* q = pool_blk(a, BK_RTQ + (h >> 1)) + off; bf16_t* k = pool_blk(a, BK_RTK + (h >> 1)) + off;
                float q1[8], q2[8], k1[8], k2[8], o1[8], o2[8];
                unpack8(rq1[u], q1); unpack8(rq2[u], q2); unpack8(rk1[u], k1); unpack8(rk2[u], k2);
                bf16_t* qo = dum ? q + 16 * BLK_E : q; bf16_t* ko = dum ? k + 16 * BLK_E : k;
                const float sc_ = 0.08838834764831845f;
#pragma unroll
                for (int j = 0; j < 8; ++j) { o1[j] = (q1[j] * cs[j] - q2[j] * sn[j]) * sc_; o2[j] = (q1[j] * sn[j] + q2[j] * cs[j]) * sc_; }
                *(u32x4*)qo = pack8(o1); *(u32x4*)(qo + 64) = pack8(o2);
#pragma unroll
                for (int j = 0; j < 8; ++j) { o1[j] = k1[j] * cs[j] - k2[j] * sn[j]; o2[j] = k1[j] * sn[j] + k2[j] * cs[j]; }
                *(u32x4*)ko = pack8(o1); *(u32x4*)(ko + 64) = pack8(o2); } }
        }
    }
    const bf16_t* zl = pool_blk(a, BK_RWL); bf16_t* ap = pool_blk(a, BK_LIN);
    const float* mu = FIN(I_MU) + (size_t)l * 1792 + 1536;
    {
        const int p0 = wg * 512 + tid, c0 = (p0 & 31) * 8, stride = G * 512;
        float muv[8];
#pragma unroll
        for (int j = 0; j < 8; ++j) muv[j] = mu[c0 + j];
        for (int pb = p0; pb < NTOK * 32; pb += 4 * stride) {
            u32x4 rr[4], rp[4];
#pragma unroll
            for (int u = 0; u < 4; ++u) { const int p = pb + u * stride; if (p < NTOK * 32) { const int n = p >> 5, t = n & (T - 1);
                rr[u] = *(const u32x4*)(zl + (size_t)n * 256 + c0); rp[u] = (t > 0) ? *(const u32x4*)(zl + (size_t)(n - 1) * 256 + c0) : (u32x4){0u, 0u, 0u, 0u}; } }
#pragma unroll
            for (int u = 0; u < 4; ++u) { const int p = pb + u * stride; if (p < NTOK * 32) { const int n = p >> 5;
                float raw[8], prev[8], o[8];
                unpack8(rr[u], raw); unpack8(rp[u], prev);
#pragma unroll
                for (int j = 0; j < 8; ++j) { const float zs = raw[j] + muv[j] * (prev[j] - raw[j]);
                    o[j] = c0 < 64 ? tanhf(zs) : (c0 < 128 ? zs : sigm(zs)); }
                *(u32x4*)(ap + (size_t)n * 256 + c0) = pack8(o); } }
        }
    }
}


DEV void s1_trfrag2(const LAS unsigned char* img, int ct, int lane, bf16x8 (&f)[2]) {
    const int fq = lane >> 4, q = (lane & 15) >> 2, p = lane & 3;
    const unsigned a0 = (unsigned)(size_t)img + (8 * fq + q) * 272 + (16 * ct + 4 * p) * 2;
    typedef unsigned short u16x4_ __attribute__((ext_vector_type(4)));
    u16x4_ r0, r1, r2, r3;
    asm volatile("ds_read_b64_tr_b16 %0, %4\n\tds_read_b64_tr_b16 %1, %4 offset:1088\n\tds_read_b64_tr_b16 %2, %4 offset:8704\n\tds_read_b64_tr_b16 %3, %4 offset:9792\n\ts_waitcnt lgkmcnt(0)"
                 : "=&v"(r0), "=&v"(r1), "=&v"(r2), "=&v"(r3) : "v"(a0) : "memory");
    f[0] = (bf16x8){(short)r0[0], (short)r0[1], (short)r0[2], (short)r0[3], (short)r1[0], (short)r1[1], (short)r1[2], (short)r1[3]};
    f[1] = (bf16x8){(short)r2[0], (short)r2[1], (short)r2[2], (short)r2[3], (short)r3[0], (short)r3[1], (short)r3[2], (short)r3[3]};
}
DEV void phase_scan_chunk(KA& a, LAS unsigned char* lds, int l, const bool dum = false) {
    const int tid = opaque_tid(), lane = tid & 63, wave = tid >> 6, G = gridDim.x, wg = blockIdx.x;
    constexpr int SQ = 272, SK = 144;
    constexpr int O_QE = 0, O_KE = 17408, O_KT = 34816, O_VT = 53248, BUFSZ = 57856;
    constexpr int O_ST = 2 * BUFSZ, STSZ = 8704, O_P = O_ST + 2 * STSZ, PSZ = 9216;
    static_assert(O_P + PSZ <= LDS_MISC, "LDS map");
    const int fr = lane & 15, fq = lane >> 4;
    const int ti = wave >> 1, vi = wave & 1;
    const float* side = (const float*)(a.ws + WS_HGSIDE);
    for (int it0 = wg; it0 < 256; it0 += G) {
        const int item = (G == 256) ? (((it0 & 7) * 8 + (it0 >> 5)) * 4 + ((it0 >> 3) & 3)) : it0;
        const int type = item >> 7, b = (item >> 4) & 7, h = (item >> 2) & 3, j = item & 3;
        const bf16_t* gq = pool_blk(a, (type ? BK_RTQ : BK_HGQ) + (h >> 1)) + (h & 1) * 128;
        const bf16_t* gk = pool_blk(a, (type ? BK_RTK : BK_HGF) + (h >> 1)) + (h & 1) * 128;
        bf16_t* gv = pool_blk(a, (type ? BK_RTV : BK_HGI) + (h >> 1)) + (h & 1) * 128 + j * 32;
        bf16_t* go = dum ? pool_blk(a, 30 + (h >> 1)) + (h & 1) * 128 + j * 32 : gv;
        const float lg2g = log2f(1.f - exp2f(-5.f - (float)h));
        const float g64 = exp2f(64.f * lg2g);
        __syncthreads();
        for (int i = tid; i < (2 * STSZ + PSZ) / 4; i += 512) ((LAS unsigned*)(lds + O_ST))[i] = 0u;
        u32x4 rqA[2], rkA[2], rvA[2], rqB[2], rkB[2], rvB[2];
        f32x4 S0 = (f32x4){0.f, 0.f, 0.f, 0.f}, S1 = S0;
        const int rp = tid >> 4, ch = tid & 15, rpv = (tid >> 2) & 31, chv = tid & 3;
        const float zv0 = type ? exp2f((float)(63 - 2 * rpv) * lg2g) : 1.f, zv1 = type ? exp2f((float)(62 - 2 * rpv) * lg2g) : 1.f;
        float mk[2][4], rsc[4];
#pragma unroll
        for (int q = 0; q < 2; ++q)
#pragma unroll
            for (int r = 0; r < 4; ++r) { const int t = 16 * ti + 4 * fq + r, s_ = 16 * (2 * (wave & 1) + q) + fr; mk[q][r] = (t >= s_) ? (type ? exp2f((float)(t - 63) * lg2g) : 1.f) : 0.f; }
#pragma unroll
        for (int r = 0; r < 4; ++r) rsc[r] = type ? exp2f((float)(16 * ti + 4 * fq + r + 1) * lg2g) : 1.f;
#define SC_LOAD(RQ, RK_, RV, cc) do { const size_t n0_ = (size_t)b * T + (size_t)(cc) * 64; \
            _Pragma("unroll") for (int i = 0; i < 2; ++i) { RQ[i] = *(const u32x4*)(gq + (n0_ + 2 * rp + i) * 256 + ch * 8); RK_[i] = *(const u32x4*)(gk + (n0_ + 2 * rp + i) * 256 + ch * 8); } \
            if (tid < 128) { _Pragma("unroll") for (int i = 0; i < 2; ++i) RV[i] = *(const u32x4*)(gv + (n0_ + 2 * rpv + i) * 256 + chv * 8); } } while (0)
#define SC_WRITE(RQ, RK_, RV, pb) do { LAS unsigned char* B_ = lds + (pb) * BUFSZ; \
            _Pragma("unroll") for (int i = 0; i < 2; ++i) { *(LAS u32x4*)(B_ + O_QE + (2 * rp + i) * SQ + ch * 16) = RQ[i]; *(LAS u32x4*)(B_ + O_KE + (2 * rp + i) * SQ + ch * 16) = RK_[i]; } \
            if (tid < 128) { float v0_[8], v1_[8]; unpack8(RV[0], v0_); unpack8(RV[1], v1_);     \
                _Pragma("unroll") for (int e = 0; e < 8; ++e) \
                    *(LAS unsigned*)(B_ + O_VT + (chv * 8 + e) * SK + (((rpv >> 2) ^ chv) * 16) + (rpv & 3) * 4) = pk2(v0_[e] * zv0, v1_[e] * zv1); } } while (0)
#define SC_KT(row, kc) (O_KT + (row) * SK + ((((kc)) ^ (((row) >> 3) & 7)) * 16))
#define SC_VT(row, kc) (O_VT + (row) * SK + ((((kc)) ^ (((row) >> 3) & 3)) * 16))
#define SC_SIDE(A_, B_, E_, cc) do { _Pragma("unroll") for (int q = 0; q < 2; ++q) { const int d = 16 * (2 * (wave >> 1) + q) + fr; \
            if (type == 0 && (cc) < 64) { const float* sp = side + ((size_t)(b * 64 + (cc)) * 4 + h) * 384 + d; A_[q] = sp[128]; B_[q] = sp[256]; E_[q] = ((cc) + 1 < 64) ? sp[4 * 384] : 1.f; } \
            else { A_[q] = g64; B_[q] = 1.f; E_[q] = 1.f; } } } while (0)
#define SC_BODY(c, pb, LQ, LK, LV, WQ, WK, WV) do { \
            LAS unsigned char* B = lds + (pb) * BUFSZ; \
            const size_t n0 = (size_t)b * T + (size_t)(c) * 64; \
            SC_SIDE(na, nb, ne, (c) + 1);     \
            if ((c) + 2 < 64) SC_LOAD(LQ, LK, LV, (c) + 2); \
            bf16x8 qf[4];     \
            _Pragma("unroll") for (int kk = 0; kk < 4; ++kk) qf[kk] = *(const LAS bf16x8*)(B + O_QE + (16 * ti + fr) * SQ + (32 * kk + 8 * fq) * 2); \
            _Pragma("unroll") for (int q = 0; q < 2; ++q) { const int si = 2 * (wave & 1) + q; \
                if (si <= ti) { \
                    f32x4 acc = (f32x4){0.f, 0.f, 0.f, 0.f}, acc2 = acc;     \
                    _Pragma("unroll") for (int kk = 0; kk < 4; ++kk) { const bf16x8 af = qf[kk]; \
                        const bf16x8 bf = *(const LAS bf16x8*)(B + O_KE + (16 * si + fr) * SQ + (32 * kk + 8 * fq) * 2); \
                        if (kk & 1) acc2 = __builtin_amdgcn_mfma_f32_16x16x32_bf16(af, bf, acc2, 0, 0, 0); else acc = __builtin_amdgcn_mfma_f32_16x16x32_bf16(af, bf, acc, 0, 0, 0); } \
                    acc += acc2; \
                    _Pragma("unroll") for (int r = 0; r < 4; ++r) { const int t = 16 * ti + 4 * fq + r, s_ = 16 * si + fr; \
                        *(LAS bf16_t*)(lds + O_P + t * SK + s_ * 2) = (bf16_t)f2bf(acc[r] * mk[q][r]); } \
                } } \
            LDS_BARRIER(); \
            { \
                f32x4 acc = (f32x4){0.f, 0.f, 0.f, 0.f}, acc2 = acc, accp = acc;     \
                _Pragma("unroll") for (int kk = 0; kk < 4; ++kk) { const bf16x8 af = qf[kk]; \
                    const bf16x8 bf = *(const LAS bf16x8*)(lds + O_ST + (pb) * STSZ + (16 * vi + fr) * SQ + (32 * kk + 8 * fq) * 2); \
                    if (kk & 1) acc2 = __builtin_amdgcn_mfma_f32_16x16x32_bf16(af, bf, acc2, 0, 0, 0); else acc = __builtin_amdgcn_mfma_f32_16x16x32_bf16(af, bf, acc, 0, 0, 0); } \
                _Pragma("unroll") for (int kk = 0; kk < 2; ++kk) if (kk == 0 || ti >= 2) { const bf16x8 af = *(const LAS bf16x8*)(lds + O_P + (16 * ti + fr) * SK + (32 * kk + 8 * fq) * 2); \
                    const bf16x8 bf = *(const LAS bf16x8*)(B + SC_VT(16 * vi + fr, 4 * kk + fq)); \
                    accp = __builtin_amdgcn_mfma_f32_16x16x32_bf16(af, bf, accp, 0, 0, 0); } \
                _Pragma("unroll") for (int r = 0; r < 4; ++r) acc[r] = (acc[r] + acc2[r]) * rsc[r] + accp[r]; \
                _Pragma("unroll") for (int r = 0; r < 4; ++r) go[(n0 + 16 * ti + 4 * fq + r) * 256 + 16 * vi + fr] = (bf16_t)f2bf(acc[r]); \
            } \
            _Pragma("unroll") for (int q = 0; q < 2; ++q) { const int di = 2 * (wave >> 1) + q; \
                f32x4 acc = (f32x4){0.f, 0.f, 0.f, 0.f}; \
                bf16x8 ktf[2]; s1_trfrag2(B + O_KE, di, lane, ktf);     \
                _Pragma("unroll") for (int kk = 0; kk < 2; ++kk) { const bf16x8 af = *(const LAS bf16x8*)(B + SC_VT(16 * vi + fr, 4 * kk + fq)); \
                    acc = __builtin_amdgcn_mfma_f32_16x16x32_bf16(af, ktf[kk], acc, 0, 0, 0); } \
                f32x4 Sn = (q == 0 ? S0 : S1) * sa[q] + acc * sb[q]; \
                if (q == 0) S0 = Sn; else S1 = Sn; \
                _Pragma("unroll") for (int r = 0; r < 4; ++r) *(LAS bf16_t*)(lds + O_ST + ((pb) ^ 1) * STSZ + (16 * vi + 4 * fq + r) * SQ + (16 * di + fr) * 2) = (bf16_t)f2bf(Sn[r] * se[q]); \
            } \
            if ((c) + 1 < 64) SC_WRITE(WQ, WK, WV, (pb) ^ 1); \
            _Pragma("unroll") for (int q = 0; q < 2; ++q) { sa[q] = na[q]; sb[q] = nb[q]; se[q] = ne[q]; } \
            LDS_BARRIER(); } while (0)
        float sa[2], sb[2], se[2], na[2], nb[2], ne[2];
        SC_SIDE(sa, sb, se, 0);
        SC_LOAD(rqA, rkA, rvA, 0);
        SC_WRITE(rqA, rkA, rvA, 0);
        SC_LOAD(rqA, rkA, rvA, 1);
        LDS_BARRIER();
        for (int c = 0; c < 64; c += 2) {
            SC_BODY(c, 0, rqB, rkB, rvB, rqA, rkA, rvA);
            SC_BODY(c + 1, 1, rqA, rkA, rvA, rqB, rkB, rvB);
        }
#undef SC_BODY
#undef SC_SIDE
#undef SC_KT
#undef SC_VT
#undef SC_LOAD
#undef SC_WRITE
    }
}

#define DPPF(x, ctrl, rmask) __builtin_bit_cast(float, __builtin_amdgcn_update_dpp(0, __builtin_bit_cast(int, x), ctrl, rmask, 0xF, true))
DEV float row16_sum_f(float x) { x += DPPF(x, 0xB1, 0xF); x += DPPF(x, 0x4E, 0xF); x += DPPF(x, 0x141, 0xF); x += DPPF(x, 0x140, 0xF); return x; }
DEV float wave_sum_dpp(float x) {
    x = row16_sum_f(x);
    x += __builtin_bit_cast(float, __builtin_amdgcn_update_dpp(0, __builtin_bit_cast(int, x), 0x142, 0xA, 0xF, false));
    x += __builtin_bit_cast(float, __builtin_amdgcn_update_dpp(0, __builtin_bit_cast(int, x), 0x143, 0xC, 0xF, false));
    return __builtin_bit_cast(float, __builtin_amdgcn_readlane(__builtin_bit_cast(int, x), 63));
}
typedef unsigned short u16x4 __attribute__((ext_vector_type(4)));
constexpr int CW_S = 144;
constexpr int CW_IMG = 64 * CW_S;
DEV unsigned lds_addr(const LAS unsigned char* p) { return (unsigned)(size_t)p; }
DEV bf16x8 cw_rowfrag(const LAS unsigned char* img, int rt, int kk, int fr, int fq) { return *(const LAS bf16x8*)(img + (16 * rt + fr) * CW_S + (32 * kk + 8 * fq) * 2); }
DEV void cw_trfrag2(const LAS unsigned char* img, int ct, int lane, bf16x8 (&f)[2]) {
    const int fq = lane >> 4, q = (lane & 15) >> 2, p = lane & 3;
    const unsigned a0 = lds_addr(img) + (8 * fq + q) * CW_S + (16 * ct + 4 * p) * 2;
    u16x4 r0, r1, r2, r3;
    asm volatile("ds_read_b64_tr_b16 %0, %4\n\tds_read_b64_tr_b16 %1, %4 offset:576\n\tds_read_b64_tr_b16 %2, %4 offset:4608\n\tds_read_b64_tr_b16 %3, %4 offset:5184\n\ts_waitcnt lgkmcnt(0)"
                 : "=&v"(r0), "=&v"(r1), "=&v"(r2), "=&v"(r3) : "v"(a0) : "memory");
    f[0] = (bf16x8){(short)r0[0], (short)r0[1], (short)r0[2], (short)r0[3], (short)r1[0], (short)r1[1], (short)r1[2], (short)r1[3]};
    f[1] = (bf16x8){(short)r2[0], (short)r2[1], (short)r2[2], (short)r2[3], (short)r3[0], (short)r3[1], (short)r3[2], (short)r3[3]};
}
template <bool ATR, bool BTR> DEV void cw_mm(const LAS unsigned char* Aimg, const LAS unsigned char* Bimg, int mt, int nt0, int lane, f32x4 (&acc)[2]) {
    const int fr = lane & 15, fq = lane >> 4;
    bf16x8 af[2], bf0[2], bf1[2];
    if (ATR) cw_trfrag2(Aimg, mt, lane, af); else { af[0] = cw_rowfrag(Aimg, mt, 0, fr, fq); af[1] = cw_rowfrag(Aimg, mt, 1, fr, fq); }
    if (BTR) { cw_trfrag2(Bimg, nt0, lane, bf0); cw_trfrag2(Bimg, nt0 + 1, lane, bf1); }
    else { bf0[0] = cw_rowfrag(Bimg, nt0, 0, fr, fq); bf0[1] = cw_rowfrag(Bimg, nt0, 1, fr, fq); bf1[0] = cw_rowfrag(Bimg, nt0 + 1, 0, fr, fq); bf1[1] = cw_rowfrag(Bimg, nt0 + 1, 1, fr, fq); }
    asm volatile("s_waitcnt lgkmcnt(0)" ::: "memory"); __builtin_amdgcn_sched_barrier(0);
#pragma unroll
    for (int kk = 0; kk < 2; ++kk) { acc[0] = __builtin_amdgcn_mfma_f32_16x16x32_bf16(af[kk], bf0[kk], acc[0], 0, 0, 0); acc[1] = __builtin_amdgcn_mfma_f32_16x16x32_bf16(af[kk], bf1[kk], acc[1], 0, 0, 0); }
}
DEV void cw_put(LAS unsigned char* img, int mt, int nt, int lane, const f32x4 v) {
    const int fr = lane & 15, fq = lane >> 4;
    u32x2 w; w.x = pk2(v[0], v[1]); w.y = pk2(v[2], v[3]);
    *(LAS u32x2*)(img + (16 * nt + fr) * CW_S + (16 * mt + 4 * fq) * 2) = w;
}
DEV void cw_trfrag4(const LAS unsigned char* imgA, int ctA, const LAS unsigned char* imgB, int ctB, int lane, bf16x8 (&fa)[2], bf16x8 (&fb)[2]) {
    const int fq = lane >> 4, q = (lane & 15) >> 2, p = lane & 3;
    const unsigned a0 = lds_addr(imgA) + (8 * fq + q) * CW_S + (16 * ctA + 4 * p) * 2, b0 = lds_addr(imgB) + (8 * fq + q) * CW_S + (16 * ctB + 4 * p) * 2;
    u16x4 r0, r1, r2, r3, r4, r5, r6, r7;
    asm volatile("ds_read_b64_tr_b16 %0, %8\n\tds_read_b64_tr_b16 %1, %8 offset:576\n\tds_read_b64_tr_b16 %2, %8 offset:4608\n\tds_read_b64_tr_b16 %3, %8 offset:5184\n\t"
                 "ds_read_b64_tr_b16 %4, %9\n\tds_read_b64_tr_b16 %5, %9 offset:576\n\tds_read_b64_tr_b16 %6, %9 offset:4608\n\tds_read_b64_tr_b16 %7, %9 offset:5184\n\ts_waitcnt lgkmcnt(0)"
                 : "=&v"(r0), "=&v"(r1), "=&v"(r2), "=&v"(r3), "=&v"(r4), "=&v"(r5), "=&v"(r6), "=&v"(r7) : "v"(a0), "v"(b0) : "memory");
    fa[0] = (bf16x8){(short)r0[0], (short)r0[1], (short)r0[2], (short)r0[3], (short)r1[0], (short)r1[1], (short)r1[2], (short)r1[3]};
    fa[1] = (bf16x8){(short)r2[0], (short)r2[1], (short)r2[2], (short)r2[3], (short)r3[0], (short)r3[1], (short)r3[2], (short)r3[3]};
    fb[0] = (bf16x8){(short)r4[0], (short)r4[1], (short)r4[2], (short)r4[3], (short)r5[0], (short)r5[1], (short)r5[2], (short)r5[3]};
    fb[1] = (bf16x8){(short)r6[0], (short)r6[1], (short)r6[2], (short)r6[3], (short)r7[0], (short)r7[1], (short)r7[2], (short)r7[3]};
}
#define CW_MMA(ACC, AF, B0, B1) do { _Pragma("unroll") for (int kk_ = 0; kk_ < 2; ++kk_) { \
        ACC[0] = __builtin_amdgcn_mfma_f32_16x16x32_bf16(AF[kk_], B0[kk_], ACC[0], 0, 0, 0); ACC[1] = __builtin_amdgcn_mfma_f32_16x16x32_bf16(AF[kk_], B1[kk_], ACC[1], 0, 0, 0); } } while (0)
#define CW_ZERO(X) X[0] = X[1] = (f32x4){0.f, 0.f, 0.f, 0.f}
#define CW_FENCE() do { asm volatile("s_waitcnt lgkmcnt(0)" ::: "memory"); __builtin_amdgcn_sched_barrier(0); } while (0)
constexpr size_t PO_CWPQ = 0;
constexpr size_t PO_CWRO = 8 * BLK_B;
typedef short bf16x4 __attribute__((ext_vector_type(4)));
DEV bf16x4 cvt4(const f32x4 v) { u32x2 w; w.x = pk2(v[0], v[1]); w.y = pk2(v[2], v[3]); return __builtin_bit_cast(bf16x4, w); }
DEV bf16x8 cat8(const bf16x4 a, const bf16x4 b) { return __builtin_shufflevector(a, b, 0, 1, 2, 3, 4, 5, 6, 7); }
DEV bf16x4 lo4(const bf16x8 v) { return __builtin_shufflevector(v, v, 0, 1, 2, 3); }
DEV bf16x4 hi4(const bf16x8 v) { return __builtin_shufflevector(v, v, 4, 5, 6, 7); }
DEV f32x4 up4(const bf16x4 v) { const u32x2 w = __builtin_bit_cast(u32x2, v); return (f32x4){bf2f(w.x & 0xffffu), __uint_as_float(w.x & 0xffff0000u), bf2f(w.y & 0xffffu), __uint_as_float(w.y & 0xffff0000u)}; }
#define MF16(A, B, C) __builtin_amdgcn_mfma_f32_16x16x16bf16_1k(A, B, C, 0, 0, 0)
#define MF32(A, B, C) __builtin_amdgcn_mfma_f32_16x16x32_bf16(A, B, C, 0, 0, 0)
constexpr int CW_AT = 0, CW_RT = 1, CW_BH = 2, CW_KH = 3;
constexpr int CWF = 4 * CW_IMG;
constexpr int CWF_AT = CWF, CWF_BH = CWF + 8192, CWF_KH = CWF + 16384, CWF_V = CWF + 24576;
constexpr int CWM = CWF + 4 * 8192;
constexpr int CWM_AB = CWM, CWM_AK = CWM + 8192, CWM_RB = CWM + 16384, CWM_RK = CWM + 24576;
constexpr int CWT = CWM + 4 * 8192;
constexpr int CW_SIDE = CWT + 2048;
static_assert(CW_SIDE + (8 * 64 + 3 * 64) * 4 <= LDS_MISC, "RW1 LDS map");
DEV void phase_rw1(KA& a, LAS unsigned char* lds, int l) {
    const int tid = opaque_tid(), lane = tid & 63, wave = tid >> 6, G = gridDim.x, wg = blockIdx.x;
    const int fr = lane & 15, fq = lane >> 4, mt = wave >> 1, nt0 = 2 * (wave & 1);
    float* RK = (float*)(a.ws + WS_RK);
    LAS float* side = (LAS float*)(lds + CW_SIDE);
#define IMG(i) (lds + (i) * CW_IMG)
    unsigned gr[8], gk[8], gv[8], glw[8], gla[8], gpr = 0, gpk = 0, gpv = 0;
    float pmur = 0.f, pmuk = 0.f, pmuv = 0.f, pw0 = 0.f, pa0 = 0.f, pkkp = 0.f, pkap = 0.f, prkp = 0.f;
#define RW1_LOAD(ci_) do { const int c_ = (ci_) & 63, h_ = ((ci_) >> 6) & 7, b_ = (ci_) >> 9, hb_ = h_ >> 2, cb_ = (h_ & 3) * 64 + (lane & ~1); \
        const size_t n_ = (size_t)b_ * T + c_ * 64 + wave * 8; \
        const unsigned* zr_ = (const unsigned*)(pool_blk(a, BK_RWR + hb_) + cb_); const unsigned* zk_ = (const unsigned*)(pool_blk(a, BK_RWK + hb_) + cb_); const unsigned* zv_ = (const unsigned*)(pool_blk(a, BK_RWV + hb_) + cb_); \
        const unsigned* lwp_ = (const unsigned*)(pool_blk(a, BK_LW + hb_) + cb_); const unsigned* lap_ = (const unsigned*)(pool_blk(a, BK_LA + hb_) + cb_); \
        _Pragma("unroll") for (int q = 0; q < 8; ++q) { gr[q] = zr_[(n_ + q) * 128]; gk[q] = zk_[(n_ + q) * 128]; gv[q] = zv_[(n_ + q) * 128]; glw[q] = lwp_[(n_ + q) * 128]; gla[q] = lap_[(n_ + q) * 128]; } \
        if ((n_ & (T - 1)) > 0) { gpr = zr_[(n_ - 1) * 128]; gpk = zk_[(n_ - 1) * 128]; gpv = zv_[(n_ - 1) * 128]; } else { gpr = 0; gpk = 0; gpv = 0; } \
        { const int ch_ = h_ * 64 + lane; pmur = FIN(I_MU)[l * 1792 + ch_]; pmuk = FIN(I_MU)[l * 1792 + 512 + ch_]; pmuv = FIN(I_MU)[l * 1792 + 1024 + ch_]; \
          pw0 = FIN(I_W0)[l * 512 + ch_]; pa0 = FIN(I_A0)[l * 512 + ch_]; pkkp = FIN(I_KK)[l * 512 + ch_]; pkap = FIN(I_KA)[l * 512 + ch_]; prkp = FIN(I_RK)[l * 512 + ch_]; } } while (0)
    const unsigned gsel = (lane & 1) ? 0x07060c0cu : 0x05040c0cu;
#define BFS(w) __uint_as_float(__builtin_amdgcn_perm((w), 0u, gsel))
    for (int i = tid; i < (4 * 8192 + 2048) / 4; i += 512) ((LAS unsigned*)(lds + CWM))[i] = 0u;
    if (wg < NB * 8 * 64) RW1_LOAD(wg);
    for (int ci = wg; ci < NB * 8 * 64; ci += G) {
        const int h = (ci >> 6) & 7, b = ci >> 9, c = ci & 63;
        const size_t n0 = (size_t)b * T + c * 64 + wave * 8;
        const float mur = pmur, muk = pmuk, muv = pmuv, w0 = pw0, a0 = pa0, kkp = pkkp, kap = pkap, rkp = prkp;
        float rs[8], ks[8], vs[8], lx[8], av[8], nk[8], sq[8], rkx[8];
        {
            float rp = BFS(gpr), kp_ = BFS(gpk), vp = BFS(gpv);
#pragma unroll
            for (int q = 0; q < 8; ++q) {
                const float r0 = BFS(gr[q]), k0 = BFS(gk[q]), v0 = BFS(gv[q]);
                rs[q] = r0 + mur * (rp - r0); ks[q] = k0 + muk * (kp_ - k0); vs[q] = v0 + muv * (vp - v0); rp = r0; kp_ = k0; vp = v0;
                lx[q] = -0.8750340975f * sigm(w0 + BFS(glw[q]));
                av[q] = sigm(a0 + BFS(gla[q]));
                nk[q] = ks[q] * kkp; sq[q] = nk[q] * nk[q];
                ks[q] = ks[q] * (1.f + (av[q] - 1.f) * kap);
                rkx[q] = rs[q] * ks[q] * rkp;
            }
        }
        __builtin_amdgcn_sched_barrier(0);
        { const int cn_ = (ci + G < NB * 8 * 64) ? ci + G : ci; RW1_LOAD(cn_); }
        {
            const bool b0 = (lane & 1) != 0, b1 = (lane & 2) != 0, b2 = (lane & 4) != 0, b3 = (lane & 8) != 0;
            float u[8], w4[4], z2[2];
#pragma unroll
            for (int i = 0; i < 8; ++i) { const float a_ = (i < 4) ? sq[2 * i] : rkx[2 * i - 8], b_ = (i < 4) ? sq[2 * i + 1] : rkx[2 * i - 7]; u[i] = (b0 ? b_ : a_) + DPPF(b0 ? a_ : b_, 0xB1, 0xF); }
#pragma unroll
            for (int i = 0; i < 4; ++i) w4[i] = (b1 ? u[2 * i + 1] : u[2 * i]) + DPPF(b1 ? u[2 * i] : u[2 * i + 1], 0x4E, 0xF);
#pragma unroll
            for (int i = 0; i < 2; ++i) z2[i] = (b2 ? w4[2 * i + 1] : w4[2 * i]) + DPPF(b2 ? w4[2 * i] : w4[2 * i + 1], 0x124, 0xF);
            float y = (b3 ? z2[1] : z2[0]) + DPPF(b3 ? z2[0] : z2[1], 0x128, 0xF);
            y += __builtin_bit_cast(float, __builtin_amdgcn_ds_bpermute((lane ^ 32) * 4, __builtin_bit_cast(int, y)));
            y += __builtin_bit_cast(float, __builtin_amdgcn_ds_bpermute((lane ^ 16) * 4, __builtin_bit_cast(int, y)));
#pragma unroll
            for (int q = 0; q < 8; ++q) { sq[q] = __builtin_bit_cast(float, __builtin_amdgcn_readlane(__builtin_bit_cast(int, y), q)); rkx[q] = __builtin_bit_cast(float, __builtin_amdgcn_readlane(__builtin_bit_cast(int, y), 8 + q)); }
        }
        float cl[8];
        { float run = 0.f;
#pragma unroll
          for (int q = 0; q < 8; ++q) { nk[q] = -nk[q] * __builtin_amdgcn_rsqf(fmaxf(sq[q], 1e-24f)); run += lx[q]; cl[q] = run; }
          if (lane == 0) {
#pragma unroll
              for (int q = 0; q < 8; ++q) RK[(n0 + q) * 8 + h] = rkx[q]; }
          side[wave * 64 + lane] = run; }
        LDS_BARRIER();
        float off = 0.f, ref = 0.f, tot = 0.f;
#pragma unroll
        for (int w2 = 0; w2 < 8; ++w2) { const float tv = side[w2 * 64 + lane]; if (w2 < wave) off += tv; if (w2 < 4) ref += tv; tot += tv; }
        const float eref = __builtin_amdgcn_exp2f(ref);
        if (wave == 0) { side[512 + lane] = eref; side[576 + lane] = __builtin_amdgcn_exp2f(tot); side[640 + lane] = __builtin_amdgcn_exp2f(tot - ref); }
        {
            float fa[8], fb[8], fk[8], fat[8], frt[8];
            float eprev = __builtin_amdgcn_exp2f(off - ref);
#pragma unroll
            for (int q = 0; q < 8; ++q) {
                const float ci_ = off + cl[q];
                const float eu = __builtin_amdgcn_exp2f(ci_ - ref), ed = __builtin_amdgcn_exp2f(ref - ci_), ep = eprev; eprev = eu;
                fat[q] = nk[q] * ep; frt[q] = rs[q] * eu; fb[q] = -nk[q] * av[q] * ed; fk[q] = ks[q] * ed; fa[q] = fat[q] * eref;
            }
            unsigned pa[4], pr[4], pb[4], pk[4], pe[4], pv[4];
#pragma unroll
            for (int i = 0; i < 4; ++i) { pa[i] = pk2(fat[2 * i], fat[2 * i + 1]); pr[i] = pk2(frt[2 * i], frt[2 * i + 1]); pb[i] = pk2(fb[2 * i], fb[2 * i + 1]); pk[i] = pk2(fk[2 * i], fk[2 * i + 1]);
                pe[i] = pk2(fa[2 * i], fa[2 * i + 1]); pv[i] = pk2(vs[2 * i], vs[2 * i + 1]); }
#pragma unroll
            for (int i = 0; i < 4; ++i) { const int t = wave * 8 + 2 * i;
                *(LAS bf16_t*)(IMG(CW_AT) + t * CW_S + lane * 2) = (bf16_t)(pa[i] & 0xffffu); *(LAS bf16_t*)(IMG(CW_AT) + (t + 1) * CW_S + lane * 2) = (bf16_t)(pa[i] >> 16);
                *(LAS bf16_t*)(IMG(CW_RT) + t * CW_S + lane * 2) = (bf16_t)(pr[i] & 0xffffu); *(LAS bf16_t*)(IMG(CW_RT) + (t + 1) * CW_S + lane * 2) = (bf16_t)(pr[i] >> 16);
                *(LAS bf16_t*)(IMG(CW_BH) + t * CW_S + lane * 2) = (bf16_t)(pb[i] & 0xffffu); *(LAS bf16_t*)(IMG(CW_BH) + (t + 1) * CW_S + lane * 2) = (bf16_t)(pb[i] >> 16);
                *(LAS bf16_t*)(IMG(CW_KH) + t * CW_S + lane * 2) = (bf16_t)(pk[i] & 0xffffu); *(LAS bf16_t*)(IMG(CW_KH) + (t + 1) * CW_S + lane * 2) = (bf16_t)(pk[i] >> 16); }
#pragma unroll
            for (int qh = 0; qh < 2; ++qh) {
                const int so = (((lane >> 4) * 2 + (wave >> 2)) * 64 + (2 * (wave & 1) + qh) * 16 + (lane & 15)) * 16 + ((wave >> 1) & 1) * 8;
                *(LAS u32x2*)(lds + CWF_AT + so) = (u32x2){pe[2 * qh], pe[2 * qh + 1]};
                *(LAS u32x2*)(lds + CWF_BH + so) = (u32x2){pb[2 * qh], pb[2 * qh + 1]};
                *(LAS u32x2*)(lds + CWF_KH + so) = (u32x2){pk[2 * qh], pk[2 * qh + 1]};
                *(LAS u32x2*)(lds + CWF_V + so) = (u32x2){pv[2 * qh], pv[2 * qh + 1]};
            }
        }
        LDS_BARRIER();
#define LD2(F, img, blk) do { F[0] = cw_rowfrag(IMG(img), (blk), 0, fr, fq); F[1] = cw_rowfrag(IMG(img), (blk), 1, fr, fq); } while (0)
#define MM2(XA, YB) MF32(XA[1], YB[1], MF32(XA[0], YB[0], Z0))
#define PUTM(base, i, j, C) (*(LAS bf16x4*)(lds + (base) + (((i) * 2 + ((j) >> 1)) * 64 + lane) * 16 + ((j) & 1) * 8) = cvt4(C))
        const f32x4 Z0 = {0.f, 0.f, 0.f, 0.f};
        if (wave < 4) {
            const int i = wave;
            bf16x8 ya[2], xb[2]; LD2(ya, CW_AT, i); LD2(xb, CW_BH, i);
            f32x4 X = MM2(ya, xb), Xt = MM2(xb, ya), St;
#pragma unroll
            for (int r = 0; r < 4; ++r) { X[r] = (4 * fq + r > fr) ? X[r] : 0.f; Xt[r] = (fr > 4 * fq + r) ? Xt[r] : 0.f; St[r] = Xt[r] + ((4 * fq + r == fr) ? 1.f : 0.f); }
            const bf16x4 c0 = cvt4(X), c0t = cvt4(Xt);
            const f32x4 P1 = MF16(c0t, c0, Z0), P1t = MF16(c0, c0t, Z0);
            const bf16x4 c1 = cvt4(P1), c1t = cvt4(P1t);
            St = MF16(c1, cvt4(St), St);
            const f32x4 P2 = MF16(c1t, c1, Z0), P2t = MF16(c1, c1t, Z0);
            const bf16x4 c2 = cvt4(P2), c2t = cvt4(P2t);
            St = MF16(c2, cvt4(St), St);
            const f32x4 P3 = MF16(c2t, c2, Z0);
            St = MF16(cvt4(P3), cvt4(St), St);
            *(LAS bf16x4*)(lds + CWT + (i * 64 + lane) * 8) = cvt4(St);
        } else {
            const int u = wave - 4;
            {
                bf16x8 xb[2], xk[2], ya[2], yr[2]; LD2(xb, CW_BH, u); LD2(xk, CW_KH, u); LD2(ya, CW_AT, u); LD2(yr, CW_RT, u);
                f32x4 ak = MM2(xk, ya), rb = MM2(xb, yr), rk = MM2(xk, yr);
#pragma unroll
                for (int r = 0; r < 4; ++r) { ak[r] = (fr > 4 * fq + r) ? ak[r] : 0.f; rb[r] = (fr >= 4 * fq + r) ? rb[r] : 0.f; rk[r] = (fr >= 4 * fq + r) ? rk[r] : 0.f; }
                PUTM(CWM_AK, u, u, ak); PUTM(CWM_RB, u, u, rb); PUTM(CWM_RK, u, u, rk);
            }
            {
                const int i = (u == 0) ? 1 : (u == 3 ? 3 : 2), j = u >> 1;
                bf16x8 xb[2], xk[2], ya[2], yr[2]; LD2(xb, CW_BH, j); LD2(xk, CW_KH, j); LD2(ya, CW_AT, i); LD2(yr, CW_RT, i);
                PUTM(CWM_AB, i, j, MM2(xb, ya)); PUTM(CWM_AK, i, j, MM2(xk, ya)); PUTM(CWM_RB, i, j, MM2(xb, yr)); PUTM(CWM_RK, i, j, MM2(xk, yr));
            }
            {
                const int j = (u < 2) ? 0 : 2;
                bf16x8 xb[2], xk[2], y[2]; LD2(xb, CW_BH, j); LD2(xk, CW_KH, j);
                if (u & 1) { LD2(y, CW_RT, 3); PUTM(CWM_RB, 3, j, MM2(xb, y)); PUTM(CWM_RK, 3, j, MM2(xk, y)); }
                else       { LD2(y, CW_AT, 3); PUTM(CWM_AB, 3, j, MM2(xb, y)); PUTM(CWM_AK, 3, j, MM2(xk, y)); }
            }
        }
        LDS_BARRIER();
        {
            const int kind = wave >> 2, st = wave & 3;
            unsigned char* gpq = a.ws + WS_POOL + PO_CWPQ + (size_t)ci * 16384; unsigned char* gro = a.ws + WS_POOL + PO_CWRO + (size_t)ci * 16384;
#define FM64(base, i, j) (*(const LAS bf16x4*)(lds + (base) + (((i) * 2 + ((j) >> 1)) * 64 + lane) * 16 + ((j) & 1) * 8))
#define FM128(base, i, jp) (*(const LAS bf16x8*)(lds + (base) + (((i) * 2 + (jp)) * 64 + lane) * 16))
#define MFP(A8, B8, C) MF32(A8, B8, C)
#define LTRI(OUT, base, ACC, B01, B23) do { \
                OUT[0] = MFP(FM128(base, 0, 0), B01, ACC[0]); OUT[1] = MFP(FM128(base, 1, 0), B01, ACC[1]); \
                OUT[2] = MFP(FM128(base, 2, 1), B23, MFP(FM128(base, 2, 0), B01, ACC[2])); OUT[3] = MFP(FM128(base, 3, 1), B23, MFP(FM128(base, 3, 0), B01, ACC[3])); } while (0)
#define LTRIT(OUT, base, ACC, A01, A23) do { \
                OUT[0] = MFP(A01, FM128(base, 0, 0), ACC[0]); OUT[1] = MFP(A01, FM128(base, 1, 0), ACC[1]); \
                OUT[2] = MFP(A23, FM128(base, 2, 1), MFP(A01, FM128(base, 2, 0), ACC[2])); OUT[3] = MFP(A23, FM128(base, 3, 1), MFP(A01, FM128(base, 3, 0), ACC[3])); } while (0)
            bf16x4 ft[4];
#pragma unroll
            for (int i = 0; i < 4; ++i) ft[i] = *(const LAS bf16x4*)(lds + CWT + (i * 64 + lane) * 8);
            const bf16x4 ab10 = FM64(CWM_AB, 1, 0); const bf16x8 ab2 = FM128(CWM_AB, 2, 0), ab3 = FM128(CWM_AB, 3, 0), ab3h = FM128(CWM_AB, 3, 1);
            f32x4 R[4]; bf16x8 vf[2] = {};
            if (kind == 0) { const bf16x8 r01 = FM128(CWF_AT, st, 0), r23 = FM128(CWF_AT, st, 1); R[0] = up4(lo4(r01)); R[1] = up4(hi4(r01)); R[2] = up4(lo4(r23)); R[3] = up4(hi4(r23)); }
            else { vf[0] = FM128(CWF_V, st, 0); vf[1] = FM128(CWF_V, st, 1); const f32x4 zz[4] = {Z0, Z0, Z0, Z0}; LTRI(R, CWM_AK, zz, vf[0], vf[1]); }
            bf16x4 c[4];
            c[0] = cvt4(MF16(ft[0], cvt4(R[0]), Z0));
            c[1] = cvt4(MF16(ft[1], cvt4(MF16(ab10, c[0], R[1])), Z0));
            const bf16x8 c01 = cat8(c[0], c[1]);
            c[2] = cvt4(MF16(ft[2], cvt4(MFP(ab2, c01, R[2])), Z0));
            c[3] = cvt4(MF16(ft[3], cvt4(MFP(ab3h, cat8(c[2], c[2]), MFP(ab3, c01, R[3]))), Z0));
            const bf16x8 c23 = cat8(c[2], c[3]);
            const int col = 16 * st + fr;
            if (kind == 0) {
                const f32x4 er4 = *(const LAS f32x4*)(side + 512 + 16 * st + 4 * fq);
                f32x4 xr[4];
#pragma unroll
                for (int i = 0; i < 4; ++i) xr[i] = up4(*(const LAS bf16x4*)(IMG(CW_RT) + (16 * i + fr) * CW_S + (16 * st + 4 * fq) * 2)) * er4;
                LTRIT(xr, CWM_RB, xr, c01, c23);
#pragma unroll
                for (int i = 0; i < 4; ++i) {
                    const f32x4 xp = MFP(c23, FM128(CWF_BH, i, 1), MFP(c01, FM128(CWF_BH, i, 0), Z0));
                    const float etr = side[640 + 16 * i + fr], etot = side[576 + 16 * i + fr];
                    f32x4 pv;
#pragma unroll
                    for (int r = 0; r < 4; ++r) pv[r] = xp[r] * etr + ((i == st && 4 * fq + r == fr) ? etot : 0.f);
                    *(bf16x4*)(gro + ((i * 2 + (st >> 1)) * 64 + lane) * 16 + (st & 1) * 8) = cvt4(xr[i]);
                    *(bf16x4*)(gpq + ((i * 2 + (st >> 1)) * 64 + lane) * 16 + (st & 1) * 8) = cvt4(pv);
                }
            } else {
                f32x4 xo[4]; { const f32x4 zz[4] = {Z0, Z0, Z0, Z0}; LTRI(xo, CWM_RB, zz, c01, c23); }
                LTRI(xo, CWM_RK, xo, vf[0], vf[1]);
#pragma unroll
                for (int i = 0; i < 4; ++i) {
                    f32x4 xq = MFP(FM128(CWF_BH, i, 1), c23, MFP(FM128(CWF_BH, i, 0), c01, Z0));
                    xq = MFP(FM128(CWF_KH, i, 1), vf[1], MFP(FM128(CWF_KH, i, 0), vf[0], xq));
                    u32x2 w; w.x = pk2(xo[i][0], xo[i][1]); w.y = pk2(xo[i][2], xo[i][3]); *(u32x2*)(gro + 8192 + ((i * 4 + st) * 64 + lane) * 8) = w;
                    const f32x4 et4 = *(const LAS f32x4*)(side + 640 + 16 * i + 4 * fq);
                    w.x = pk2(xq[0] * et4[0], xq[1] * et4[1]); w.y = pk2(xq[2] * et4[2], xq[3] * et4[3]);
                    *(u32x2*)(gpq + 8192 + ((i * 4 + st) * 64 + lane) * 8) = w;
                }
            }
#undef FM64
#undef FM128
#undef MFP
#undef LTRI
#undef LTRIT
        }
#undef LD2
#undef MM2
#undef PUTM
    }
#undef IMG
#undef RW1_LOAD
#undef BFS
}
template <int PART> DEV void mpost_tokens(KA& a, int l, int n_lo, int n_hi, int w0, int wstride, const bool dum);
constexpr int RW2_POST_TOK = 10880;
DEV void phase_rw2(KA& a, LAS unsigned char* lds, int l, const bool dum = false) {
    const int tid = opaque_tid(), lane = tid & 63, wave = __builtin_amdgcn_readfirstlane(tid >> 6), G = gridDim.x, wg = blockIdx.x;
    const int fr = lane & 15, fq = lane >> 4, mt = wave >> 1, nt0 = 2 * (wave & 1);
    constexpr int RING = 16384, SLOT = 32768;
    static_assert(RING + 4 * SLOT <= LDS_MISC, "RW2 LDS map");
    for (int item = wg; item < 256; item += G) {
        const int qd = 3 - (item >> 6), bh = item & 63, h = bh & 7, b = bh >> 3, hb = h >> 2, cb = (h & 3) * 64;
        const int nsteps = 16 * qd + 16, c_out = 16 * qd;
        bf16_t* op = pool_blk(a, (dum ? 30 : BK_RWO) + hb) + cb;
        const unsigned char* gpq = a.ws + WS_POOL + PO_CWPQ + (size_t)bh * 64 * 16384 + tid * 16; const unsigned char* gro = a.ws + WS_POOL + PO_CWRO + (size_t)bh * 64 * 16384 + tid * 16;
        __syncthreads();
        for (int i = tid; i < 2 * 8192 / 4; i += 512) ((LAS unsigned*)lds)[i] = 0u;
#define RW2_ISSUE(s) do { const int s_ = (s); const int r_ = s_ < nsteps ? s_ : nsteps - 1; LAS unsigned char* d_ = lds + RING + (s_ & 3) * SLOT + wave * 1024; \
            const unsigned char* p_ = gpq + (size_t)r_ * 16384; \
            __builtin_amdgcn_global_load_lds((const unsigned*)p_, (LAS unsigned*)d_, 16, 0, 0); __builtin_amdgcn_global_load_lds((const unsigned*)(p_ + 8192), (LAS unsigned*)(d_ + 8192), 16, 0, 0); \
            if (s_ >= c_out) { const unsigned char* q_ = gro + (size_t)r_ * 16384; \
                __builtin_amdgcn_global_load_lds((const unsigned*)q_, (LAS unsigned*)(d_ + 16384), 16, 0, 0); __builtin_amdgcn_global_load_lds((const unsigned*)(q_ + 8192), (LAS unsigned*)(d_ + 24576), 16, 0, 0); } } while (0)
        RW2_ISSUE(0); RW2_ISSUE(1); RW2_ISSUE(2);
        asm volatile("s_waitcnt vmcnt(4)" ::: "memory");
        LDS_BARRIER();
        for (int c = 0; c < nsteps; ++c) {
            RW2_ISSUE(c + 3);
            const LAS unsigned char* Hc = lds + (c & 1) * 8192; LAS unsigned char* Hn = lds + ((c + 1) & 1) * 8192;
            const LAS unsigned char* sl = lds + RING + (c & 3) * SLOT;
            bf16x8 hb0[2], hb1[2];
            hb0[0] = *(const LAS bf16x8*)(Hc + ((nt0 * 2) * 64 + lane) * 16); hb0[1] = *(const LAS bf16x8*)(Hc + ((nt0 * 2 + 1) * 64 + lane) * 16);
            hb1[0] = *(const LAS bf16x8*)(Hc + ((nt0 * 2 + 2) * 64 + lane) * 16); hb1[1] = *(const LAS bf16x8*)(Hc + ((nt0 * 2 + 3) * 64 + lane) * 16);
            const bf16x8 paf0 = *(const LAS bf16x8*)(sl + ((mt * 2) * 64 + lane) * 16), paf1 = *(const LAS bf16x8*)(sl + ((mt * 2 + 1) * 64 + lane) * 16);
            f32x4 hn[2];
            hn[0] = up4(*(const LAS bf16x4*)(sl + 8192 + ((mt * 4 + nt0) * 64 + lane) * 8)); hn[1] = up4(*(const LAS bf16x4*)(sl + 8192 + ((mt * 4 + nt0 + 1) * 64 + lane) * 8));
            hn[0] = __builtin_amdgcn_mfma_f32_16x16x32_bf16(paf0, hb0[0], hn[0], 0, 0, 0); hn[0] = __builtin_amdgcn_mfma_f32_16x16x32_bf16(paf1, hb0[1], hn[0], 0, 0, 0);
            hn[1] = __builtin_amdgcn_mfma_f32_16x16x32_bf16(paf0, hb1[0], hn[1], 0, 0, 0); hn[1] = __builtin_amdgcn_mfma_f32_16x16x32_bf16(paf1, hb1[1], hn[1], 0, 0, 0);
            *(LAS bf16x4*)(Hn + ((nt0 * 2 + (mt >> 1)) * 64 + lane) * 16 + (mt & 1) * 8) = cvt4(hn[0]); *(LAS bf16x4*)(Hn + ((nt0 * 2 + 2 + (mt >> 1)) * 64 + lane) * 16 + (mt & 1) * 8) = cvt4(hn[1]);
            if (c >= c_out) {
                const bf16x8 raf0 = *(const LAS bf16x8*)(sl + 16384 + ((mt * 2) * 64 + lane) * 16), raf1 = *(const LAS bf16x8*)(sl + 16384 + ((mt * 2 + 1) * 64 + lane) * 16);
                f32x4 o[2];
                o[0] = up4(*(const LAS bf16x4*)(sl + 24576 + ((mt * 4 + nt0) * 64 + lane) * 8)); o[1] = up4(*(const LAS bf16x4*)(sl + 24576 + ((mt * 4 + nt0 + 1) * 64 + lane) * 8));
                o[0] = __builtin_amdgcn_mfma_f32_16x16x32_bf16(raf0, hb0[0], o[0], 0, 0, 0); o[0] = __builtin_amdgcn_mfma_f32_16x16x32_bf16(raf1, hb0[1], o[0], 0, 0, 0);
                o[1] = __builtin_amdgcn_mfma_f32_16x16x32_bf16(raf0, hb1[0], o[1], 0, 0, 0); o[1] = __builtin_amdgcn_mfma_f32_16x16x32_bf16(raf1, hb1[1], o[1], 0, 0, 0);
                const size_t nb_ = (size_t)b * T + (size_t)c * 64;
#pragma unroll
                for (int j = 0; j < 2; ++j)
#pragma unroll
                    for (int r = 0; r < 4; ++r) op[(nb_ + 16 * mt + 4 * fq + r) * 256 + 16 * (nt0 + j) + fr] = (bf16_t)f2bf(o[j][r]);
            }
            if (c - 2 >= c_out) asm volatile("s_waitcnt vmcnt(32)" ::: "memory"); else asm volatile("s_waitcnt vmcnt(4)" ::: "memory");
            LDS_BARRIER();
        }
#undef RW2_ISSUE
        asm volatile("s_waitcnt vmcnt(0)" ::: "memory");
        LDS_BARRIER();
        { const int nu = 3 - qd, u0 = bh * 6 + (qd == 0 ? 0 : (qd == 1 ? 3 : 5));
          if (nu > 0) mpost_tokens<0>(a, l, (u0 * RW2_POST_TOK) / 384, ((u0 + nu) * RW2_POST_TOK) / 384, wave, 8, dum); }
    }
}

template <int PART> DEV void mpost_tokens(KA& a, int l, int n_lo, int n_hi, int w0, int wstride, const bool dum) {
    const int lane = opaque_tid() & 63;
    const int c0 = 8 * lane, blk = c0 >> 8, col = c0 & 255;
    const float* RK = (const float*)(a.ws + WS_RK);
    float nw[8], lnw[8], lnb[8], muv[8];
#pragma unroll
    for (int j = 0; j < 8; ++j) { nw[j] = FIN(I_HGNW)[l * 128 + (c0 & 127) + j]; lnw[j] = FIN(I_LNW)[l * 512 + c0 + j]; lnb[j] = FIN(I_LNB)[l * 512 + c0 + j]; muv[j] = FIN(I_MU)[l * 1792 + 1024 + c0 + j]; }
    for (int nb = n_lo + w0; nb < n_hi; nb += 4 * wstride) {
        u32x4 ra[4], rb[4], rc[4], rd[4]; float rkv[4];
#pragma unroll
        for (int u = 0; u < 4; ++u) { const int n = nb + u * wstride; if (n < n_hi) { const size_t off = (size_t)n * 256 + col;
            if (PART == 0) { ra[u] = *(const u32x4*)(pool_blk(a, BK_HGI + blk) + off); rb[u] = *(const u32x4*)(pool_blk(a, BK_HGG + blk) + off);
                             rc[u] = *(const u32x4*)(pool_blk(a, BK_RTV + blk) + off); rd[u] = *(const u32x4*)(pool_blk(a, BK_RTG + blk) + off); }
            else { ra[u] = *(const u32x4*)(pool_blk(a, BK_RWO + blk) + off); rb[u] = *(const u32x4*)(pool_blk(a, BK_LG + blk) + off); rc[u] = *(const u32x4*)(pool_blk(a, BK_RWV + blk) + off);
                   rd[u] = ((n & (T - 1)) > 0) ? *(const u32x4*)(pool_blk(a, BK_RWV + blk) + off - 256) : (u32x4){0u, 0u, 0u, 0u}; rkv[u] = RK[(size_t)n * 8 + (lane >> 3)]; } } }
#pragma unroll
        for (int u = 0; u < 4; ++u) { const int n = nb + u * wstride; if (n < n_hi) {
        const size_t off = (size_t)n * 256 + col;
        float o[8], g[8], r_[8];
        if (PART == 0) {
        {
            u32x4* op = (u32x4*)(pool_blk(a, BK_HGI + blk) + off);
            unpack8(ra[u], o); unpack8(rb[u], g);
            float ss = 0.f;
#pragma unroll
            for (int j = 0; j < 8; ++j) ss += o[j] * o[j];
            ss = row16_sum(ss);
            const float r = __builtin_amdgcn_rsqf(ss * (1.f / 128.f) + NORM_EPS);
#pragma unroll
            for (int j = 0; j < 8; ++j) r_[j] = o[j] * r * nw[j] * silu(g[j]);
            *(dum ? (u32x4*)(pool_blk(a, 16 + blk) + off) : op) = pack8(r_);
        }
        {
            u32x4* op = (u32x4*)(pool_blk(a, BK_RTV + blk) + off);
            unpack8(rc[u], o); unpack8(rd[u], g);
            float ss = 0.f;
#pragma unroll
            for (int j = 0; j < 8; ++j) ss += o[j] * o[j];
            ss = row16_sum(ss);
            const float r = __builtin_amdgcn_rsqf(ss * (1.f / 128.f) + NORM_EPS);
#pragma unroll
            for (int j = 0; j < 8; ++j) r_[j] = o[j] * r * silu(g[j]);
            *(dum ? (u32x4*)(pool_blk(a, 18 + blk) + off) : op) = pack8(r_);
        }
        } else {
            float v0[8], vp[8];
            unpack8(ra[u], o);
            u32x4* gp = (u32x4*)(pool_blk(a, BK_LG + blk) + off);
            unpack8(rb[u], g); unpack8(rc[u], v0); unpack8(rd[u], vp);
            float s = 0.f;
#pragma unroll
            for (int j = 0; j < 8; ++j) s += o[j];
            const float mean = row8_sum(s) * (1.f / 64.f);
            float q = 0.f;
#pragma unroll
            for (int j = 0; j < 8; ++j) { const float dd = o[j] - mean; q += dd * dd; }
            const float var = row8_sum(q) * (1.f / 64.f);
            const float rs = __builtin_amdgcn_rsqf(var + RW_GN_EPS);
            const float rk = rkv[u];
#pragma unroll
            for (int j = 0; j < 8; ++j) { const float vs = v0[j] + muv[j] * (vp[j] - v0[j]); r_[j] = ((o[j] - mean) * rs * lnw[j] + lnb[j] + rk * vs) * g[j]; }
            *(dum ? (u32x4*)(pool_blk(a, 8 + blk) + off) : gp) = pack8(r_);
        }
        } }
    }
}
DEV void phase_mpost(KA& a, int l, const bool dum = false) {
    const int wave = opaque_tid() >> 6;
    mpost_tokens<1>(a, l, 0, NTOK, blockIdx.x * 8 + wave, gridDim.x * 8, dum);
    mpost_tokens<0>(a, l, RW2_POST_TOK, NTOK, blockIdx.x * 8 + wave, gridDim.x * 8, dum);
}

DEV void phase_gather(KA& a, LAS unsigned char* lds) {
    const int tid = opaque_tid(), lane = tid & 63, wave = tid >> 6, G = gridDim.x, wg = blockIdx.x;
    LAS int* tot = (LAS int*)lds; LAS int* base = tot + 32; LAS int* se = tot + 64; LAS int* part = tot + 64 + 256;
    const int* cnt = (const int*)(a.ws + WS_CNT); const int* sele = (const int*)(a.ws + WS_SEL_E); int* selp = (int*)(a.ws + WS_SEL_P);
    int* tilemap = (int*)(a.ws + WS_TILEMAP); int* rowtok = (int*)(a.ws + WS_ROWTOK);
    for (int grp = wg; grp < NTOK / 128; grp += G) {
        __syncthreads();
        {
            const int e = tid & 31, pt = tid >> 5; int t_ = 0, bf = 0;
#pragma unroll
            for (int i = 0; i < 16; ++i) { const int g = pt * 16 + i; const int cval = cnt[g * 32 + e]; t_ += cval; bf += (g < grp) ? cval : 0; }
            part[pt * 32 + e] = t_; part[512 + pt * 32 + e] = bf; }
        if (tid < 256) se[tid] = sele[grp * 256 + tid];
        __syncthreads();
        if (tid < 64) {
            const int e = lane & 31; int t_ = 0, bf = 0;
#pragma unroll
            for (int i = 0; i < 16; ++i) { t_ += part[i * 32 + e]; bf += part[512 + i * 32 + e]; }
            const int mt = (t_ + 255) >> 8; int incl = mt;
#pragma unroll
            for (int d = 1; d < 32; d <<= 1) { const int v = __builtin_amdgcn_ds_bpermute(((lane - d) & 63) * 4, incl); if (e >= d) incl += v; }
            const int excl = incl - mt;
            if (lane < 32) { tot[e] = t_; base[e] = bf + excl * 256;
                if (grp == 0) { for (int k = 0; k < mt; ++k) tilemap[1 + excl + k] = e; if (e == 31) tilemap[0] = incl; } } }
        __syncthreads();
#pragma unroll
        for (int q = 0; q < 4; ++q) { const int e = wave * 4 + q; int run = base[e];
#pragma unroll
            for (int k = 0; k < 4; ++k) { const int i = 64 * k + lane; const bool hit = se[i] == e; const unsigned long long m = __ballot(hit);
                if (hit) { const int p = run + (int)__builtin_amdgcn_mbcnt_hi((unsigned)(m >> 32), __builtin_amdgcn_mbcnt_lo((unsigned)m, 0u)); selp[grp * 256 + i] = p; rowtok[p] = grp * 128 + (i >> 1); }
                run += __popcll(m); } }
        if (grp == 0) {
            for (int e = 0; e < 32; ++e) { const int cnt_e = tot[e], end_e = ((cnt_e + 255) >> 8) << 8; for (int p = cnt_e + tid; p < end_e; p += 512) rowtok[base[e] + p] = 0; } }
        __syncthreads();
    }
}

constexpr int PH_PER_LAYER = 17, PH_FINAL = 1 + 2 * PH_PER_LAYER, PH_COUNT = PH_FINAL + 1;
#ifndef MK_PHMASK
#define MK_PHMASK 0x7ffffull
#endif
#define IN(k) (lo <= (k) && (k) < hi)
#define PH(k, idx) (IN(k) && ((MK_PHMASK >> (idx)) & 1ull))
#ifndef MK_REP_IDX
#define MK_REP_IDX -1
#endif
#ifndef MK_REP_L
#define MK_REP_L -1
#endif
#define REP(idx) for (int rep_ = 0; rep_ < ((MK_REP_IDX == (idx) && (MK_REP_L < 0 || MK_REP_L == l)) ? 2 : 1); ++rep_)
#define SEAM(k) do { if (IN(k) && IN((k) + 1)) xcd_barrier(bar); } while (0)
#define KARGS() (*({ KA* ap_ = (KA*)__builtin_amdgcn_kernarg_segment_ptr(); asm volatile("" : "+s"(ap_)); ap_; }))
#define POOL ((bf16_t*)(a.ws + WS_POOL))
#define HBUF ((bf16_t*)(a.ws + WS_H))
template <int L> DEV void run_layer(LAS unsigned char* lds, const int lo, const int hi, const XcdBarrier& bar) {
    constexpr int l = L;
    const int G = gridDim.x, wg = blockIdx.x;
        const int pb = 1 + PH_PER_LAYER * l;
#define WINT ((const bf16_t*)(a.ws + WS_WIN) + (size_t)l * INC * 1024)
        if (PH(pb + 0, 0)) REP(0) { KA& a = KARGS(); if (l == 0) phase_norm<0>(a, lds, 0); else phase_norm<1>(a, lds, l); }
        SEAM(pb + 0);
        if (PH(pb + 1, 1)) REP(1) { KA& a = KARGS(); pg8::Gemm g{HBUF, WINT, 1024, 1024, 512, 0, 0}; pg8::DenseOrder S; S.init(NTOK, ZMIXC, G, wg, 0); pg8::EpiBlk<0, 0> E{POOL};
            pg8::gemm_phase(lds, g, S, E);
            if (l == 0 && G == 256 && wg >= 128 && rep_ == 0) { const int t_ = opaque_tid(); dense_weight_transposes(a, (LAS float*)(lds + (t_ >> 6) * 8448), 1, (wg - 128) * 8 + (t_ >> 6), 1024, t_ & 63); } }
        SEAM(pb + 1);
        if (PH(pb + 2, 2)) REP(2) { KA& a = KARGS(); phase_mpre(a, lds, l, MK_REP_IDX == 2 && rep_ == 0); }
        SEAM(pb + 2);
        if (PH(pb + 3, 3)) REP(3) { KA& a = KARGS(); pg8::Gemm g{pool_blk(a, BK_LIN), (const bf16_t*)(a.ws + WS_LORAB) + (size_t)l * 1536 * 256, 256, 256, 512, 0, 0}; pg8::DenseOrder S; S.init(NTOK, 1536, G, wg, 0); pg8::EpiBlk<1, 0> E{POOL};
            pg8::gemm_phase(lds, g, S, E); }
        if (PH(pb + 4, 4)) REP(4) { KA& a = KARGS();
            phase_scan_chunk(a, lds, l, MK_REP_IDX == 4 && rep_ == 0);
        }
        SEAM(pb + 4);
        if (PH(pb + 5, 5)) REP(5) { KA& a = KARGS(); phase_rw1(a, lds, l); }
        SEAM(pb + 5);
        if (PH(pb + 6, 6)) REP(6) { KA& a = KARGS(); phase_rw2(a, lds, l, MK_REP_IDX == 6 && rep_ == 0); }
        SEAM(pb + 6);
        if (PH(pb + 7, 7)) REP(7) { KA& a = KARGS(); phase_mpost(a, l, MK_REP_IDX == 7 && rep_ == 0); }
        SEAM(pb + 7);
        if (PH(pb + 8, 8)) REP(8) { KA& a = KARGS(); pg8::Gemm g{HBUF, WINT, 1024, 1024, 512, 0, 0}; pg8::DenseOrder S; S.init(NTOK, GATEC, G, wg, ZMIXC / 256); pg8::EpiBlk<2, 1> E{POOL};
            pg8::gemm_phase(lds, g, S, E); }
        SEAM(pb + 8);
        {
#define YF32 ((float*)pool_blk(a, BK_YF))
#define YBF ((bf16_t*)pool_blk(a, BK_YB))
#define BRT ((const bf16_t*)(a.ws + WS_BR) + (size_t)l * 1024 * 1536)
            if (PH(pb + 9, 9)) REP(9) { KA& a = KARGS(); pg8::Gemm g{pool_blk(a, BK_HGI), BRT, 1536, 256, BLK_B, (size_t)(BK_RTV - BK_HGI) * BLK_B, (size_t)(BK_LG - BK_HGI) * BLK_B}; pg8::DenseOrder S; S.init(NTOK, 1024, G, wg, 0, 8);
                pg8::EpiHorner E{POOL, YBF};
                pg8::gemm_phase<true>(lds, g, S, E); }
            SEAM(pb + 11);
        }
        if (PH(pb + 12, 12)) REP(12) { KA& a = KARGS(); pg8::Gemm g{pool_blk(a, BK_YB), (const bf16_t*)(a.ws + WS_WOUT) + (size_t)l * 1024 * 1024, 1024, 256, BLK_B, 0, 0}; pg8::DenseOrder S; S.init(NTOK, 1024, G, wg, 0, 8);
            if (l == 0) { pg8::EpiResid<true> E{FIN(I_X), (bf16_t*)a.out, (const float*)(a.ws + WS_MOD) + (size_t)l * 8 * 6144 + 2048}; pg8::gemm_phase(lds, g, S, E); }
            else { pg8::EpiResid<false> E{nullptr, (bf16_t*)a.out, (const float*)(a.ws + WS_MOD) + (size_t)l * 8 * 6144 + 2048}; pg8::gemm_phase(lds, g, S, E); } }
        SEAM(pb + 12);
        if (PH(pb + 13, 13)) REP(13) { KA& a = KARGS(); phase_norm<2>(a, lds, l); }
        SEAM(pb + 13);
        if (PH(pb + 14, 14)) REP(14) { KA& a = KARGS(); phase_gather(a, lds); }
        SEAM(pb + 14);
        if (PH(pb + 15, 15)) REP(15) { KA& a = KARGS(); pg8::Gemm g{HBUF, (const bf16_t*)(a.ws + WS_POOL + PO_W13), 1024, 1024, 512, 0, 0}; pg8::MoeOrder S; S.init((const int*)(a.ws + WS_TILEMAP), G, (G % 8 == 0) ? (wg % 8) * (G / 8) + wg / 8 : wg, (const int*)(a.ws + WS_ROWTOK));
            pg8::EpiSwiglu E{(bf16_t*)(a.ws + WS_POOL + PO_ACT)};
            pg8::gemm_phase<false, true>(lds, g, S, E); }
        SEAM(pb + 15);
        if (PH(pb + 16, 16)) REP(16) { KA& a = KARGS(); pg8::Gemm g{(const bf16_t*)(a.ws + WS_POOL + PO_ACT), (const bf16_t*)(a.ws + WS_POOL + PO_W2), 512, 512, 512, 0, 0}; pg8::MoeOrder S; S.init((const int*)(a.ws + WS_TILEMAP), G, (G % 8 == 0) ? (wg % 8) * (G / 8) + wg / 8 : wg);
            pg8::EpiRowBf16 E{(bf16_t*)(a.ws + WS_POOL + PO_Y2), 1024};
            pg8::gemm_phase(lds, g, S, E); }
        SEAM(pb + 16);
    }
__global__ void __launch_bounds__(512, 2) mk_fwd(Args a_unused) {
    extern __shared__ __attribute__((aligned(16))) unsigned char lds_raw[];
    LAS unsigned char* lds = (LAS unsigned char*)lds_raw;
    volatile LAS unsigned* misc = (volatile LAS unsigned*)(lds + LDS_MISC);
    if (threadIdx.x < 16) misc[threadIdx.x] = 0u;
    __syncthreads();
    int lo, hi; XcdBarrier bar;
    { KA& a = KARGS(); lo = a.ph_lo; hi = a.ph_hi; bar.bar = (unsigned*)(a.ws + WS_CTL); bar.x = 0; bar.st = misc;
      if (hi - lo > 1) bar = xcd_barrier_post((unsigned*)(a.ws + WS_CTL), misc); }

    constexpr int l = 0;
    if (PH(0, 17)) REP(17) { KA& a = KARGS(); phase_prologue(a, lds); }
    SEAM(0);
    run_layer<0>(lds, lo, hi, bar);
    run_layer<1>(lds, lo, hi, bar);
    if (PH(PH_FINAL, 18)) REP(18) { KA& a = KARGS(); phase_norm<3>(a, lds, 0); }
#undef IN
#undef PH
#undef SEAM
}

extern "C" void kernel_launch(void* const* d_in, const int* in_sizes, int n_in, void* d_out, int out_size, void* d_ws, size_t ws_size, hipStream_t stream) {
    static int grid = 0;
    if (grid == 0) {
        if (n_in != 31 || in_sizes[0] != NTOK * D || out_size != NTOK * D || ws_size < WS_END) {
            fprintf(stderr, "kernel_launch: unexpected shapes (n_in %d, in0 %d, out %d, ws %zu; need ws >= %zu); nothing launched\n", n_in, n_in > 0 ? in_sizes[0] : -1, out_size, ws_size, (size_t)WS_END); grid = -1; return; }
        int dev = 0, cus = 0, per_cu = 0;
        if (hipGetDevice(&dev) != hipSuccess || hipDeviceGetAttribute(&cus, hipDeviceAttributeMultiprocessorCount, dev) != hipSuccess) { grid = -1; return; }
        if (hipFuncSetAttribute((const void*)mk_fwd, hipFuncAttributeMaxDynamicSharedMemorySize, LDS_BYTES) != hipSuccess) { fprintf(stderr, "kernel_launch: hipFuncSetAttribute failed\n"); grid = -1; return; }
        if (hipOccupancyMaxActiveBlocksPerMultiprocessor(&per_cu, (const void*)mk_fwd, 512, LDS_BYTES) != hipSuccess || per_cu < 1) { fprintf(stderr, "kernel_launch: occupancy query says %d\n", per_cu); grid = -1; return; }
        grid = cus;
    }
    if (grid < 0) return;
    if (hipMemsetAsync((char*)d_ws + WS_CTL, 0, CTL_ZERO_BYTES, stream) != hipSuccess) return;
    Args a{};
    for (int i = 0; i < 31; ++i) a.in[i] = d_in[i];
    a.out = (float*)d_out; a.ws = (unsigned char*)d_ws;
#if MK_LAUNCH_PER_PHASE
    for (int ph = 0; ph < PH_COUNT; ++ph) { a.ph_lo = ph; a.ph_hi = ph + 1; hipLaunchKernelGGL(mk_fwd, dim3(grid), dim3(512), LDS_BYTES, stream, a); }
#else
    a.ph_lo = 0; a.ph_hi = PH_COUNT; hipLaunchKernelGGL(mk_fwd, dim3(grid), dim3(512), LDS_BYTES, stream, a);
#endif
}
```
